# Optimizing an MI355X kernel written in HIP

```python
import jax, jax.numpy as jnp
from jax import lax
import numpy as np

D_MODEL = 2048
BATCH = 16
SEQ = 256
DEPTH = 1
DEC_BATCH = 4
DEC_SEQ = 2048
PAST_LEN = 256

GRID_W = 64
D_FF = 5504
N_MOD = 9
GLA_HEADS = 4
GLA_DK = 256
GLA_DV = 512
GLA_QK_DIM = 1024
GLA_V_DIM = 2048
GLA_GATE_RANK = 16
GLA_TAU = 16.0
GLA_CHUNK = 64
MLA_HEADS = 16
MLA_NOPE = 128
MLA_ROPE = 64
MLA_V = 128
Q_LORA = 512
KV_LORA = 512
ROPE_THETA = 10000.0
Q_BLOCK = 128
NORM_EPS = 1e-6
PROJ_SPLITS = (1024, 1024, 2048, 2048, 16, 16, 512, 512, 64, 2048, 2048)
D_IN_PROJ = 11360

kernel_name = "hybrid_gla_mla_diffusion_step"


def rms_norm(x, g):
    xf = x.astype(jnp.float32)
    y = xf * lax.rsqrt(jnp.mean(xf * xf, axis=-1, keepdims=True) + NORM_EPS)
    return (y * g.astype(jnp.float32)).astype(x.dtype)


def swiglu(h, w_in, w_out):
    g, u = jnp.split(h @ w_in, 2, axis=-1)
    return (jax.nn.silu(g) * u) @ w_out


def axial_rope_tables(n_tokens):
    rows = n_tokens // GRID_W
    row = jnp.repeat(jnp.arange(rows), GRID_W).astype(jnp.float32)
    col = jnp.tile(jnp.arange(GRID_W), rows).astype(jnp.float32)
    half = MLA_ROPE // 2
    inv_freq = ROPE_THETA ** (-jnp.arange(0, half, 2, dtype=jnp.float32) / half)
    ang = jnp.stack([row[:, None] * inv_freq, col[:, None] * inv_freq], axis=1)
    ang = ang[:, :, None, :]
    return jnp.cos(ang), jnp.sin(ang)


def apply_axial_rope(x, cos, sin):
    xp = x.astype(jnp.float32).reshape(x.shape[:-1] + (2, 2, MLA_ROPE // 4))
    x1, x2 = xp[..., 0:1, :], xp[..., 1:2, :]
    out = jnp.concatenate([x1 * cos - x2 * sin, x2 * cos + x1 * sin], axis=-2)
    return out.reshape(x.shape).astype(x.dtype)


def gla_chunked(q, k, v, log_a, s0):
    B, T, H, K = q.shape
    V = v.shape[-1]
    n = T // GLA_CHUNK
    f32 = jnp.float32

    def chunks(t):
        return t.astype(f32).reshape(B, n, GLA_CHUNK, H, t.shape[-1])

    qc, kc, vc = chunks(q), chunks(k), chunks(v)
    b = jnp.cumsum(chunks(log_a), axis=2)
    b_last = b[:, :, -1:]
    q_dec = qc * jnp.exp(b)
    k_inv = kc * jnp.exp(-b)
    k_end = kc * jnp.exp(b_last - b)
    lower = jnp.tril(jnp.ones((GLA_CHUNK, GLA_CHUNK), dtype=bool))
    a = jnp.einsum("bnihk,bnjhk->bnhij", q_dec, k_inv)
    a = jnp.where(lower, a, 0.0)
    o_intra = jnp.einsum("bnhij,bnjhv->bnihv", a, vc)

    def step(S, xs):
        q_n, k_n, v_n, dec_n = xs
        o_n = jnp.einsum("bihk,bhkv->bihv", q_n, S)
        S = jnp.exp(dec_n)[..., None] * S + jnp.einsum("bjhk,bjhv->bhkv", k_n, v_n)
        return S, o_n

    xs = (q_dec.swapaxes(0, 1), k_end.swapaxes(0, 1), vc.swapaxes(0, 1), b_last[:, :, 0].swapaxes(0, 1))
    s_fin, o_inter = lax.scan(step, s0.astype(f32), xs)
    o = o_intra + o_inter.swapaxes(0, 1)
    return o.reshape(B, T, H, V).astype(v.dtype), s_fin.astype(s0.dtype)


def mla_attention(q_nope, q_rope, k_nope, k_rope, v):
    B, T, H, _ = q_nope.shape
    nb = T // Q_BLOCK
    scale = (MLA_NOPE + MLA_ROPE) ** -0.5
    qn = q_nope.reshape(B, nb, Q_BLOCK, H, MLA_NOPE).swapaxes(0, 1)
    qr = q_rope.reshape(B, nb, Q_BLOCK, H, MLA_ROPE).swapaxes(0, 1)

    def block(args):
        qn_b, qr_b = args
        s = jnp.einsum("bqhd,bkhd->bhqk", qn_b, k_nope) + jnp.einsum("bqhr,bkr->bhqk", qr_b, k_rope)
        p = jax.nn.softmax(s.astype(jnp.float32) * scale, axis=-1)
        return jnp.einsum("bhqk,bkhd->bqhd", p.astype(v.dtype), v)

    o = lax.map(block, (qn, qr))
    return o.swapaxes(0, 1).reshape(B, T, H * MLA_V)


def token_mixer(h, ctx, w_in, w_gla_alpha, b_gla_alpha, gla_norm, w_gla_out,
                q_norm, kv_norm, w_uq, w_ukv, w_mla_out, w_out):
    B, T, _ = h.shape
    proj = h @ w_in
    (q_g, k_g, v_g, r_g, a_f, a_b, cq, ckv, k_rope, g_a, g_b) = jnp.split(
        proj, np.cumsum(PROJ_SPLITS)[:-1].tolist(), axis=-1)

    q_g = q_g.reshape(B, T, GLA_HEADS, GLA_DK) * (GLA_DK ** -0.5)
    k_g = k_g.reshape(B, T, GLA_HEADS, GLA_DK)
    v_g = v_g.reshape(B, T, GLA_HEADS, GLA_DV)
    la_f = (jax.nn.log_sigmoid((a_f @ w_gla_alpha[0] + b_gla_alpha[0]).astype(jnp.float32)) / GLA_TAU
            ).reshape(B, T, GLA_HEADS, GLA_DK)
    la_b = (jax.nn.log_sigmoid((a_b @ w_gla_alpha[1] + b_gla_alpha[1]).astype(jnp.float32)) / GLA_TAU
            ).reshape(B, T, GLA_HEADS, GLA_DK)

    cq = rms_norm(cq, q_norm)
    q = (cq @ w_uq).reshape(B, T, MLA_HEADS, MLA_NOPE + MLA_ROPE)
    q_nope, q_rope = q[..., :MLA_NOPE], q[..., MLA_NOPE:]
    ckv = rms_norm(ckv, kv_norm)

    if ctx is None:
        s0_f = jnp.zeros((B, GLA_HEADS, GLA_DK, GLA_DV), h.dtype)
        s0_b = s0_f
        ckv_all, krope_all = ckv, k_rope
    else:
        ckv_ctx, krope_ctx, s0_f, s0_b = ctx
        cos, sin = axial_rope_tables(T)
        q_rope = apply_axial_rope(q_rope, cos[:, None], sin[:, None])
        k_rope = apply_axial_rope(k_rope, cos, sin)
        ckv_all = jnp.concatenate([ckv_ctx.astype(h.dtype), ckv], axis=1)
        krope_all = jnp.concatenate([krope_ctx.astype(h.dtype), k_rope], axis=1)

    kv = (ckv_all @ w_ukv).reshape(B, ckv_all.shape[1], MLA_HEADS, MLA_NOPE + MLA_V)
    k_nope, v_m = kv[..., :MLA_NOPE], kv[..., MLA_NOPE:]
    y_mla = mla_attention(q_nope, q_rope, k_nope, krope_all, v_m) @ w_mla_out

    o_f, s_f = gla_chunked(q_g, k_g, v_g, la_f, s0_f)
    o_b, s_b = gla_chunked(jnp.flip(q_g, 1), jnp.flip(k_g, 1), jnp.flip(v_g, 1), jnp.flip(la_b, 1), s0_b)
    o = rms_norm(o_f + jnp.flip(o_b, 1), gla_norm).reshape(B, T, GLA_V_DIM) * jax.nn.silu(r_g)
    y_gla = o @ w_gla_out

    y = (jax.nn.sigmoid(g_a) * y_gla + jax.nn.sigmoid(g_b) * y_mla) @ w_out
    return y, (ckv, k_rope, s_f, s_b)


def trunk_layer(x, mod, ctx, norm_gains, w_ffn1_in, w_ffn1_out, w_ffn2_in, w_ffn2_out, mix_w):
    sh1, sc1, gt1, sh2, sc2, gt2, sh3, sc3, gt3 = jnp.split(mod, N_MOD, axis=-1)
    h = rms_norm(x, norm_gains[0]) * (1 + sc1) + sh1
    x = x + 0.5 * gt1 * rms_norm(swiglu(h, w_ffn1_in, w_ffn1_out), norm_gains[1])
    h = rms_norm(x, norm_gains[2]) * (1 + sc2) + sh2
    y, ctx_out = token_mixer(h, ctx, *mix_w)
    x = x + gt2 * rms_norm(y, norm_gains[3])
    h = rms_norm(x, norm_gains[4]) * (1 + sc3) + sh3
    x = x + 0.5 * gt3 * rms_norm(swiglu(h, w_ffn2_in, w_ffn2_out), norm_gains[5])
    return x, ctx_out


def setup_inputs(seed: int = 0) -> dict:
    key = jax.random.key(seed)
    ks = jax.random.split(key, 32)
    f32 = jnp.float32

    def nrm(k, shape, scale):
        return jax.random.normal(k, shape, f32) * scale

    H_QK = MLA_NOPE + MLA_ROPE
    return {
        "x_prompt": nrm(ks[0], (BATCH, SEQ, D_MODEL), 1.0),
        "x_sample": nrm(ks[1], (DEC_BATCH, DEC_SEQ, D_MODEL), 1.0),
        "cache_ckv": nrm(ks[2], (DEC_BATCH, DEPTH, PAST_LEN, KV_LORA), 1.0),
        "cache_krope": nrm(ks[3], (DEC_BATCH, DEPTH, PAST_LEN, MLA_ROPE), 1.0),
        "state_gla_fwd": nrm(ks[4], (DEC_BATCH, DEPTH, GLA_HEADS, GLA_DK, GLA_DV), 0.5),
        "state_gla_bwd": nrm(ks[5], (DEC_BATCH, DEPTH, GLA_HEADS, GLA_DK, GLA_DV), 0.5),
        "c": nrm(ks[6], (DEC_BATCH, D_MODEL), 1.0),
        "c_ctx": nrm(ks[7], (D_MODEL,), 1.0),
        "w_ada": nrm(ks[8], (DEPTH, D_MODEL, N_MOD * D_MODEL), 0.5 * D_MODEL ** -0.5),
        "b_ada": nrm(ks[9], (DEPTH, N_MOD * D_MODEL), 0.01),
        "norm_gains": 1.0 + nrm(ks[10], (DEPTH, 6, D_MODEL), 0.05),
        "w_ffn1_in": nrm(ks[11], (DEPTH, D_MODEL, 2 * D_FF), D_MODEL ** -0.5),
        "w_ffn1_out": nrm(ks[12], (DEPTH, D_FF, D_MODEL), D_FF ** -0.5),
        "w_ffn2_in": nrm(ks[13], (DEPTH, D_MODEL, 2 * D_FF), D_MODEL ** -0.5),
        "w_ffn2_out": nrm(ks[14], (DEPTH, D_FF, D_MODEL), D_FF ** -0.5),
        "w_in": nrm(ks[15], (DEPTH, D_MODEL, D_IN_PROJ), D_MODEL ** -0.5),
        "w_gla_alpha": nrm(ks[16], (DEPTH, 2, GLA_GATE_RANK, GLA_QK_DIM), GLA_GATE_RANK ** -0.5),
        "b_gla_alpha": nrm(ks[17], (DEPTH, 2, GLA_QK_DIM), 0.1),
        "gla_norm": 1.0 + nrm(ks[18], (DEPTH, GLA_DV), 0.05),
        "w_gla_out": nrm(ks[19], (DEPTH, GLA_V_DIM, D_MODEL), GLA_V_DIM ** -0.5),
        "q_norm": 1.0 + nrm(ks[20], (DEPTH, Q_LORA), 0.05),
        "kv_norm": 1.0 + nrm(ks[21], (DEPTH, KV_LORA), 0.05),
        "w_uq": nrm(ks[22], (DEPTH, Q_LORA, MLA_HEADS * H_QK), Q_LORA ** -0.5),
        "w_ukv": nrm(ks[23], (DEPTH, KV_LORA, MLA_HEADS * (MLA_NOPE + MLA_V)), KV_LORA ** -0.5),
        "w_mla_out": nrm(ks[24], (DEPTH, MLA_HEADS * MLA_V, D_MODEL), (MLA_HEADS * MLA_V) ** -0.5),
        "w_out": nrm(ks[25], (DEPTH, D_MODEL, D_MODEL), D_MODEL ** -0.5),
    }


def reference(x_prompt, x_sample, cache_ckv, cache_krope, state_gla_fwd, state_gla_bwd, c, c_ctx,
              w_ada, b_ada, norm_gains, w_ffn1_in, w_ffn1_out, w_ffn2_in, w_ffn2_out,
              w_in, w_gla_alpha, b_gla_alpha, gla_norm, w_gla_out,
              q_norm, kv_norm, w_uq, w_ukv, w_mla_out, w_out):
    xp, xs = x_prompt, x_sample
    new_ckv, new_krope, new_sf, new_sb = [], [], [], []
    for l in range(DEPTH):
        mix_w = (w_in[l], w_gla_alpha[l], b_gla_alpha[l], gla_norm[l], w_gla_out[l],
                 q_norm[l], kv_norm[l], w_uq[l], w_ukv[l], w_mla_out[l], w_out[l])
        ffn_w = (norm_gains[l], w_ffn1_in[l], w_ffn1_out[l], w_ffn2_in[l], w_ffn2_out[l])
        mod_ctx = (jax.nn.silu(c_ctx) @ w_ada[l] + b_ada[l])[None, None, :]
        mod_lat = (jax.nn.silu(c) @ w_ada[l] + b_ada[l])[:, None, :]
        xp, (ckv, krope, s_f, s_b) = trunk_layer(xp, mod_ctx, None, *ffn_w, mix_w)
        new_ckv.append(ckv)
        new_krope.append(krope)
        new_sf.append(s_f)
        new_sb.append(s_b)
        ctx = (cache_ckv[:, l], cache_krope[:, l], state_gla_fwd[:, l], state_gla_bwd[:, l])
        xs, _ = trunk_layer(xs, mod_lat, ctx, *ffn_w, mix_w)
    return (xp, xs, jnp.stack(new_ckv, axis=1), jnp.stack(new_krope, axis=1),
            jnp.stack(new_sf, axis=1), jnp.stack(new_sb, axis=1))
```

```cpp
#include <hip/hip_runtime.h>
#include <hip/hip_cooperative_groups.h>
#include <cstdio>
namespace cg = cooperative_groups;

typedef unsigned short bf16_t;
typedef short bf16x8 __attribute__((ext_vector_type(8)));
typedef short bf16x4 __attribute__((ext_vector_type(4)));
typedef float f32x4 __attribute__((ext_vector_type(4)));
typedef unsigned u32x2 __attribute__((ext_vector_type(2)));
typedef unsigned u32x4 __attribute__((ext_vector_type(4)));
#define LAS __attribute__((address_space(3)))

#ifndef ONLY_PHASE
#define ONLY_PHASE -1
#endif
#ifndef PROBE_DUP
#define PROBE_DUP -1
#endif
#ifndef N_LAUNCH_SPLIT
#define N_LAUNCH_SPLIT 0
#endif

constexpr int TT = 12288;
constexpr int NCTX = 4096;
constexpr int DM = 2048;
constexpr int DFF = 5504;
constexpr int KVR = 13312;
constexpr int PROJ_LD = 8192;
constexpr int SMALL_LD = 1120;
constexpr int NPHASE = 20;
constexpr int LDS_BYTES = 147456;

constexpr size_t OUT_Y = 0, OUT_CKV = 25165824, OUT_KROPE = 27262976, OUT_SF = 27525120, OUT_SB = 35913728;

constexpr size_t WS_WT_FFN_IN = 0;
constexpr size_t WS_WT_FFN_OUT = WS_WT_FFN_IN + (size_t)11008 * 2048 * 2;
constexpr size_t WS_WT_IN = WS_WT_FFN_OUT + (size_t)2048 * 5504 * 2;
constexpr size_t WS_WT_G = WS_WT_IN + (size_t)11520 * 2048 * 2;
constexpr size_t WS_WT_M = WS_WT_G + (size_t)2048 * 2048 * 2;
constexpr size_t WS_WT_UQ = WS_WT_M + (size_t)2048 * 2048 * 2;
constexpr size_t WS_WT_UKV = WS_WT_UQ + (size_t)3072 * 512 * 2;
constexpr size_t WS_WT_OUT = WS_WT_UKV + (size_t)4096 * 512 * 2;
constexpr size_t WS_MODP = WS_WT_OUT + (size_t)2048 * 2048 * 2;
constexpr size_t WS_MOD = WS_MODP + (size_t)4 * 5 * 18432 * 4;
constexpr size_t WS_ROPE = WS_MOD + (size_t)5 * 18432 * 4;
constexpr size_t WS_CNT = WS_ROPE + 8192;
constexpr size_t WS_BAR = WS_CNT + 256;
constexpr size_t WS_H = WS_BAR + 13824;
constexpr size_t WS_CQN = WS_H;
constexpr size_t WS_CKVA = WS_CQN + (size_t)TT * 512 * 2;
constexpr size_t WS_KRA = WS_CKVA + (size_t)KVR * 512 * 2;
constexpr size_t WS_ACMP = WS_KRA + (size_t)KVR * 64 * 2;
constexpr size_t WS_R1 = WS_H + (size_t)TT * 2048 * 2;
constexpr size_t WS_R2 = WS_R1 + (size_t)TT * PROJ_LD * 2;
constexpr size_t WS_SMALL = WS_R2 + (size_t)TT * 2048 * 4;
constexpr size_t WS_Q = WS_SMALL + (size_t)TT * SMALL_LD * 4;
constexpr size_t WS_VGT = WS_Q + (size_t)TT * 3072 * 2;
constexpr size_t WS_OM = WS_SMALL;
constexpr size_t WS_KN = 0;
constexpr size_t WS_VT = WS_KN + (size_t)KVR * 2048 * 2;
static_assert(WS_VT + (size_t)KVR * 2048 * 2 <= WS_WT_G, "KN/VT alias region");
constexpr size_t WS_Y1 = WS_R2 + (size_t)TT * 2048 * 2;
constexpr size_t WS_QD = 0;
constexpr size_t WS_KIT = WS_QD + (size_t)1536 * 64 * 256 * 2;
constexpr size_t WS_DEC = WS_KIT + (size_t)1536 * 64 * 256 * 2;
constexpr size_t WS_AM = WS_DEC + (size_t)1536 * 256 * 4;
static_assert(WS_AM + (size_t)1536 * 64 * 64 * 2 <= WS_WT_G, "GLA intermediates alias region");
static_assert(WS_ACMP + (size_t)TT * 32 * 4 <= WS_R1, "H alias region");
constexpr size_t WS_END = WS_VGT + (size_t)TT * 2048 * 2;

struct Params {
    const float *x_prompt, *x_sample, *cache_ckv, *cache_krope, *st_f, *st_b, *c, *c_ctx, *w_ada, *b_ada, *norm_gains,
        *w_ffn1_in, *w_ffn1_out, *w_ffn2_in, *w_ffn2_out, *w_in, *w_gla_alpha, *b_gla_alpha, *gla_norm, *w_gla_out,
        *q_norm, *kv_norm, *w_uq, *w_ukv, *w_mla_out, *w_out;
    float* out;
    char* ws;
    int phase_lo, phase_hi;
};

__device__ __forceinline__ unsigned cvt_pk_bf16(float lo, float hi) { unsigned r; asm volatile("v_cvt_pk_bf16_f32 %0, %1, %2" : "=v"(r) : "v"(lo), "v"(hi)); return r; }
__device__ __forceinline__ bf16_t f2bf(float f) { unsigned u = __float_as_uint(f); u += 0x7FFFu + ((u >> 16) & 1u); return (bf16_t)(u >> 16); }
__device__ __forceinline__ float bf2f(bf16_t h) { return __uint_as_float(((unsigned)h) << 16); }
__device__ __forceinline__ float bflo(unsigned u) { return __uint_as_float(u << 16); }
__device__ __forceinline__ float bfhi(unsigned u) { return __uint_as_float(u & 0xffff0000u); }
__device__ __forceinline__ float wave_sum(float v) {
#pragma unroll
    for (int o = 32; o > 0; o >>= 1) v += __shfl_xor(v, o);
    return v;
}
__device__ __forceinline__ float sigmoidf_(float x) { return __builtin_amdgcn_rcpf(1.f + __expf(-x)); }
__device__ __forceinline__ float siluf_(float x) { return x * __builtin_amdgcn_rcpf(1.f + __expf(-x)); }

namespace pg8 {
constexpr int BM = 256, BK = 64, HALF = 128, HTB = HALF * BK * 2, NXCD = 8, WGM = 8;
__device__ __forceinline__ int lds_byte(int r, int c) { const int st = (r >> 4) * 2 + (c >> 5), rr = r & 15, cc = c & 31, ob = rr * 64 + cc * 2; return st * 1024 + (ob ^ (((ob >> 9) & 1) << 5)); }
__device__ __forceinline__ void stage_rc(int b, int& R, int& C) { const int st = b / 1024, sb = b % 1024, swz = sb ^ (((sb >> 9) & 1) << 5); R = (st >> 1) * 16 + swz / 64; C = (st & 1) * 32 + (swz % 64) / 2; }
struct Unit { int pm, pn, ks, koff, nt, seg; };
struct Gemm { const bf16_t* A; const bf16_t* Bt; int M, N, K; const bf16_t* A1; const bf16_t* Bt1; };
struct StaticOrder {
    int nM, nN, nwg, G, c, nt0, nt1, nsplit, nseg;
    __device__ void init(int M, int N, int K, int G_, int c_, int split, int nseg_ = 1) {
        nM = M / BM; nN = N / BM; nwg = nM * nN; G = G_; c = c_; nsplit = split; nseg = nseg_;
        const int ntk = K / BK;
        if (split == 2) { nt0 = ((ntk / 2) + 1) & ~1; nt1 = ntk - nt0; } else { nt0 = ntk; nt1 = 0; }
    }
    __device__ bool next(int i, Unit& u) const {
        u.seg = 0; if (nseg == 2) { u.seg = i & 1; i >>= 1; }
        long L = (long)i * G + c; if (L >= (long)nwg * nsplit) return false;
        u.ks = L >= nwg ? 1 : 0; if (u.ks) L -= nwg;
        u.koff = u.ks ? nt0 * BK : 0; u.nt = u.ks ? nt1 : nt0;
        int wgid = (int)L; { const int q = nwg / NXCD, r = nwg % NXCD, xcd = wgid % NXCD, off = wgid / NXCD; wgid = (xcd < r ? xcd * (q + 1) : r * (q + 1) + (xcd - r) * q) + off; }
        const int nig = WGM * nN, gid = wgid / nig, fm = gid * WGM, gsz = (nM - fm) < WGM ? (nM - fm) : WGM;
        u.pm = fm + ((wgid % nig) % gsz); u.pn = (wgid % nig) / gsz; return true;
    }
};
template <class Epi>
__device__ __forceinline__ void gemm_phase(LAS unsigned char* lds, const Gemm g, const StaticOrder& S, const Epi& E) {
    const int tid = threadIdx.x, wid = __builtin_amdgcn_readfirstlane(tid >> 6), lane = tid & 63, wr = wid >> 2, wc = wid & 3, fr = lane & 15, fq = lane >> 4;
    const int K = g.K;
    unsigned voffA[2];
#pragma unroll
    for (int i = 0; i < 2; ++i) { int R, C; stage_rc(tid * 16 + i * 8192, R, C); voffA[i] = (unsigned)(R * K + C) * 2u; }
    const size_t kstep = (size_t)(BK * 2);
    const size_t hstep = (size_t)HALF * K * 2;
    const size_t tstep = 2 * hstep;
    const unsigned ldsw = (unsigned)wid * 1024u;
    const int aoff = lds_byte(wr * 64 + fr, fq * 8), boff = lds_byte(wc * 32 + fr, fq * 8);
#define PG8_SA(b, h) (((b) * 2 + (h)) * HTB)
#define PG8_SB(b, h) ((4 + (b) * 2 + (h)) * HTB)
#define PG8_STAGE(bufoff, gbase, voff) do { _Pragma("unroll") for (int _i = 0; _i < 2; ++_i) \
        __builtin_amdgcn_global_load_lds((const unsigned*)((const char*)(gbase) + (voff)[_i]), (LAS unsigned*)(lds + (bufoff) + ldsw + _i * 8192), 16, 0, 0); } while (0)
#define PG8_LDA(dst, b, h) do { _Pragma("unroll") for (int m = 0; m < 4; ++m) _Pragma("unroll") for (int k = 0; k < 2; ++k) dst[m][k] = *(const LAS bf16x8*)(lds + PG8_SA(b, h) + aoff + m * 2048 + k * 1024); } while (0)
#define PG8_LDB(dst, b, h) do { _Pragma("unroll") for (int n = 0; n < 2; ++n) _Pragma("unroll") for (int k = 0; k < 2; ++k) dst[n][k] = *(const LAS bf16x8*)(lds + PG8_SB(b, h) + boff + n * 2048 + k * 1024); } while (0)
#define PG8_MMA(ai, bj, At, Bt) do { __builtin_amdgcn_s_setprio(1); _Pragma("unroll") for (int m = 0; m < 4; ++m) _Pragma("unroll") for (int n = 0; n < 2; ++n) _Pragma("unroll") for (int k = 0; k < 2; ++k) \
        acc[ai][bj][m][n] = __builtin_amdgcn_mfma_f32_16x16x32_bf16(Bt[n][k], At[m][k], acc[ai][bj][m][n], 0, 0, 0); __builtin_amdgcn_s_setprio(0); } while (0)
#define PG8_WAIT_V(n) asm volatile("s_waitcnt vmcnt(" #n ")" ::: "memory")
#define PG8_WAIT_L(n) asm volatile("s_waitcnt lgkmcnt(" #n ")" ::: "memory")
#define PG8_BAR __builtin_amdgcn_s_barrier()
#define PG8_SCHED __builtin_amdgcn_sched_barrier(0)
    Unit cur, nxt; int ui = 0;
    if (!S.next(0, cur)) return;
    f32x4 acc[2][2][4][2];
#pragma unroll
    for (int a = 0; a < 2; ++a)
#pragma unroll
        for (int b = 0; b < 2; ++b)
#pragma unroll
            for (int m = 0; m < 4; ++m)
#pragma unroll
                for (int n = 0; n < 2; ++n) acc[a][b][m][n] = (f32x4){0.f, 0.f, 0.f, 0.f};
    bf16x8 At[4][2], B0[2][2], B1[2][2];
    const char* cA = (const char*)(cur.seg ? g.A1 : g.A) + (size_t)cur.pm * tstep + (size_t)cur.koff * 2; const char* cB = (const char*)(cur.seg ? g.Bt1 : g.Bt) + (size_t)cur.pn * tstep + (size_t)cur.koff * 2;
    PG8_STAGE(PG8_SB(0, 0), cB, voffA); PG8_STAGE(PG8_SA(0, 0), cA, voffA); PG8_STAGE(PG8_SB(0, 1), cB + hstep, voffA); PG8_STAGE(PG8_SA(0, 1), cA + hstep, voffA);
    if (wr == 1) PG8_BAR;
    PG8_WAIT_V(4); PG8_BAR;
    PG8_STAGE(PG8_SB(1, 0), cB + kstep, voffA); PG8_STAGE(PG8_SA(1, 0), cA + kstep, voffA); PG8_STAGE(PG8_SB(1, 1), cB + hstep + kstep, voffA);
    PG8_WAIT_V(6); PG8_BAR;
    for (;;) {
        const bool has_next = S.next(ui + 1, nxt);
        const char* nA = has_next ? (const char*)(nxt.seg ? g.A1 : g.A) + (size_t)nxt.pm * tstep + (size_t)nxt.koff * 2 : cA; const char* nB = has_next ? (const char*)(nxt.seg ? g.Bt1 : g.Bt) + (size_t)nxt.pn * tstep + (size_t)nxt.koff * 2 : cB;
        const int nt = cur.nt;
        for (int t = 0; t < nt; t += 2) {
            const bool last = (t == nt - 2);
            const char* a1 = cA + (size_t)(t + 1) * kstep;
            const char* a2 = last ? nA : cA + (size_t)(t + 2) * kstep; const char* b2 = last ? nB : cB + (size_t)(t + 2) * kstep;
            const char* a3 = a2 + kstep; const char* b3 = b2 + kstep;
            PG8_LDB(B0, 0, 0); PG8_SCHED; PG8_LDA(At, 0, 0); PG8_STAGE(PG8_SA(1, 1), a1 + hstep, voffA);
            PG8_WAIT_L(8); PG8_BAR; PG8_WAIT_L(0); PG8_MMA(0, 0, At, B0); PG8_BAR; PG8_SCHED;
            PG8_LDB(B1, 0, 1); PG8_STAGE(PG8_SB(0, 0), b2, voffA);
            PG8_BAR; PG8_WAIT_L(0); PG8_MMA(0, 1, At, B1); PG8_BAR;
            PG8_LDA(At, 0, 1); PG8_STAGE(PG8_SA(0, 0), a2, voffA);
            PG8_BAR; PG8_WAIT_L(0); PG8_MMA(1, 0, At, B0); PG8_BAR; PG8_SCHED;
            PG8_STAGE(PG8_SB(0, 1), b2 + hstep, voffA);
            PG8_WAIT_V(6); PG8_BAR; PG8_MMA(1, 1, At, B1); PG8_BAR;
            PG8_LDB(B0, 1, 0); PG8_SCHED; PG8_LDA(At, 1, 0); PG8_STAGE(PG8_SA(0, 1), a2 + hstep, voffA);
            PG8_WAIT_L(8); PG8_BAR; PG8_WAIT_L(0); PG8_MMA(0, 0, At, B0); PG8_BAR; PG8_SCHED;
            PG8_LDB(B1, 1, 1); PG8_STAGE(PG8_SB(1, 0), b3, voffA);
            PG8_BAR; PG8_WAIT_L(0); PG8_MMA(0, 1, At, B1); PG8_BAR;
            PG8_LDA(At, 1, 1); PG8_STAGE(PG8_SA(1, 0), a3, voffA);
            PG8_BAR; PG8_WAIT_L(0); PG8_MMA(1, 0, At, B0); PG8_BAR; PG8_SCHED;
            PG8_STAGE(PG8_SB(1, 1), b3 + hstep, voffA);
            PG8_WAIT_V(6); PG8_BAR; PG8_MMA(1, 1, At, B1); PG8_BAR;
        }
        bool keep = false;
        if constexpr (Epi::TWO_SEG) { if (cur.seg == 0) { E.mid(acc, cur, wr, wc, fr, fq); keep = true; } else E(acc, cur, wr, wc, fr, fq); }
        else E(acc, cur, wr, wc, fr, fq);
        if (!has_next) break;
        if (!keep)
#pragma unroll
        for (int a = 0; a < 2; ++a)
#pragma unroll
            for (int b = 0; b < 2; ++b)
#pragma unroll
                for (int m = 0; m < 4; ++m)
#pragma unroll
                    for (int n = 0; n < 2; ++n) acc[a][b][m][n] = (f32x4){0.f, 0.f, 0.f, 0.f};
        cur = nxt; cA = nA; cB = nB; ++ui;
    }
    PG8_WAIT_V(0);
    if (wr == 0) PG8_BAR;
    PG8_BAR;
#undef PG8_SA
#undef PG8_SB
#undef PG8_STAGE
#undef PG8_LDA
#undef PG8_LDB
#undef PG8_MMA
#undef PG8_WAIT_V
#undef PG8_WAIT_L
#undef PG8_BAR
#undef PG8_SCHED
}
}
using pg8::Unit;
typedef f32x4 AccT[2][2][4][2];

#define EPI_LOOP_BEGIN \
    _Pragma("unroll") for (int ai = 0; ai < 2; ++ai) _Pragma("unroll") for (int m = 0; m < 4; ++m) { const int row = u.pm * 256 + ai * 128 + wr * 64 + m * 16 + fr; \
    _Pragma("unroll") for (int bj = 0; bj < 2; ++bj) { const int cb = u.pn * 256 + bj * 128 + wc * 32; const f32x4 v0 = acc[ai][bj][m][0], v1 = acc[ai][bj][m][1];
#define EPI_LOOP_END } }

struct EpiF32 {
    static constexpr bool TWO_SEG = false;
    bf16_t* C; int ldc; bf16_t* C1;
    __device__ __forceinline__ void operator()(const AccT& acc, const Unit& u, int wr, int wc, int fr, int fq) const {
        bf16_t* Cb = u.ks ? C1 : C;
        EPI_LOOP_BEGIN
            bf16_t* p = Cb + (size_t)row * ldc + cb + 4 * fq;
            uint2 o0, o1; o0.x = cvt_pk_bf16(v0[0], v0[1]); o0.y = cvt_pk_bf16(v0[2], v0[3]); o1.x = cvt_pk_bf16(v1[0], v1[1]); o1.y = cvt_pk_bf16(v1[2], v1[3]);
            *(uint2*)p = o0; *(uint2*)(p + 16) = o1;
        EPI_LOOP_END
    }
};
struct EpiSwiglu {
    static constexpr bool TWO_SEG = false;
    bf16_t* O;
    __device__ __forceinline__ void operator()(const AccT& acc, const Unit& u, int wr, int wc, int fr, int fq) const {
        EPI_LOOP_BEGIN
            float r[4];
#pragma unroll
            for (int j = 0; j < 4; ++j) r[j] = siluf_(v0[j]) * v1[j];
            uint2 o; o.x = cvt_pk_bf16(r[0], r[1]); o.y = cvt_pk_bf16(r[2], r[3]);
            *(uint2*)(O + (size_t)row * DFF + (cb >> 1) + 4 * fq) = o;
        EPI_LOOP_END
    }
};
struct EpiProj {
    static constexpr bool TWO_SEG = false;
    bf16_t* proj; bf16_t* vgt; float* small;
    __device__ __forceinline__ void operator()(const AccT& acc, const Unit& u, int wr, int wc, int fr, int fq) const {
        EPI_LOOP_BEGIN
            if (cb >= 2048 && cb < 4096) {
#pragma unroll
                for (int j = 0; j < 4; ++j) {
                    vgt[(size_t)(cb - 2048 + 4 * fq + j) * TT + row] = f2bf(v0[j]);
                    vgt[(size_t)(cb - 2048 + 16 + 4 * fq + j) * TT + row] = f2bf(v1[j]);
                }
            } else if (cb >= 6144 && cb < 7264) {
                float* p = small + (size_t)row * SMALL_LD + (cb - 6144) + 4 * fq; *(f32x4*)p = v0; *(f32x4*)(p + 16) = v1;
            } else if (cb < 11360) {
                const int cc = cb < 2048 ? cb : (cb < 6144 ? cb - 2048 : cb - 7264 + 4096);
                bf16_t* p = proj + (size_t)row * PROJ_LD + cc + 4 * fq;
                uint2 o0, o1; o0.x = cvt_pk_bf16(v0[0], v0[1]); o0.y = cvt_pk_bf16(v0[2], v0[3]); o1.x = cvt_pk_bf16(v1[0], v1[1]); o1.y = cvt_pk_bf16(v1[2], v1[3]);
                *(uint2*)p = o0; *(uint2*)(p + 16) = o1;
            }
        EPI_LOOP_END
    }
};
struct EpiQ {
    static constexpr bool TWO_SEG = false;
    bf16_t* Q; const float* rope;
    __device__ __forceinline__ void operator()(const AccT& acc, const Unit& u, int wr, int wc, int fr, int fq) const {
        EPI_LOOP_BEGIN
            f32x4 a = v0, b = v1;
            const int w0 = cb % 192;
            if (w0 >= 128 && row >= NCTX) {
                const int it = (row - NCTX) & 2047;
                const int pos = (w0 == 128) ? (it >> 6) : (it & 63);
                const float* rp = rope + (pos * 16 + 4 * fq) * 2;
#pragma unroll
                for (int j = 0; j < 4; ++j) { const float cs = rp[2 * j], sn = rp[2 * j + 1]; a[j] = v0[j] * cs - v1[j] * sn; b[j] = v1[j] * cs + v0[j] * sn; }
            }
            bf16_t* p = Q + (size_t)row * 3072 + cb + 4 * fq;
            uint2 o0, o1; o0.x = cvt_pk_bf16(a[0], a[1]); o0.y = cvt_pk_bf16(a[2], a[3]); o1.x = cvt_pk_bf16(b[0], b[1]); o1.y = cvt_pk_bf16(b[2], b[3]);
            *(uint2*)p = o0; *(uint2*)(p + 16) = o1;
        EPI_LOOP_END
    }
};
struct EpiKV {
    static constexpr bool TWO_SEG = false;
    bf16_t* KN; bf16_t* VT;
    __device__ __forceinline__ void operator()(const AccT& acc, const Unit& u, int wr, int wc, int fr, int fq) const {
        EPI_LOOP_BEGIN
            const int head = cb >> 8, w0 = cb & 255;
            if (w0 < 128) {
                bf16_t* p = KN + (size_t)row * 2048 + head * 128 + w0 + 4 * fq;
                uint2 o0, o1; o0.x = cvt_pk_bf16(v0[0], v0[1]); o0.y = cvt_pk_bf16(v0[2], v0[3]); o1.x = cvt_pk_bf16(v1[0], v1[1]); o1.y = cvt_pk_bf16(v1[2], v1[3]);
                *(uint2*)p = o0; *(uint2*)(p + 16) = o1;
            } else {
                const int dv = head * 128 + (w0 - 128) + 4 * fq;
#pragma unroll
                for (int j = 0; j < 4; ++j) { VT[(size_t)(dv + j) * KVR + row] = f2bf(v0[j]); VT[(size_t)(dv + 16 + j) * KVR + row] = f2bf(v1[j]); }
            }
        EPI_LOOP_END
    }
};
struct EpiGate {
    static constexpr bool TWO_SEG = true;
    const bf16_t* proj; bf16_t* Mo;
    __device__ __forceinline__ void mid(AccT& acc, const Unit& u, int wr, int wc, int fr, int fq) const {
#pragma unroll
        for (int ai = 0; ai < 2; ++ai) {
            uint2 ga[4][2][2], gb[4][2][2];
#pragma unroll
            for (int m = 0; m < 4; ++m)
#pragma unroll
                for (int bj = 0; bj < 2; ++bj) {
                    const int row = u.pm * 256 + ai * 128 + wr * 64 + m * 16 + fr, cb = u.pn * 256 + bj * 128 + wc * 32;
                    const bf16_t* gp = proj + (size_t)row * PROJ_LD + 4096 + cb + 4 * fq;
                    { const u32x2 t0 = __builtin_nontemporal_load((const u32x2*)gp), t1 = __builtin_nontemporal_load((const u32x2*)(gp + 16)), t2 = __builtin_nontemporal_load((const u32x2*)(gp + 2048)), t3 = __builtin_nontemporal_load((const u32x2*)(gp + 2048 + 16));
                      ga[m][bj][0] = (uint2){t0.x, t0.y}; ga[m][bj][1] = (uint2){t1.x, t1.y}; gb[m][bj][0] = (uint2){t2.x, t2.y}; gb[m][bj][1] = (uint2){t3.x, t3.y}; }
                }
#pragma unroll
            for (int m = 0; m < 4; ++m)
#pragma unroll
                for (int bj = 0; bj < 2; ++bj)
#pragma unroll
                    for (int n = 0; n < 2; ++n) {
                        const uint2 a = ga[m][bj][n], bb = gb[m][bj][n];
                        f32x4 r;
                        r[0] = (1.f + __expf(-bflo(bb.x))) * __builtin_amdgcn_rcpf(1.f + __expf(-bflo(a.x))); r[1] = (1.f + __expf(-bfhi(bb.x))) * __builtin_amdgcn_rcpf(1.f + __expf(-bfhi(a.x)));
                        r[2] = (1.f + __expf(-bflo(bb.y))) * __builtin_amdgcn_rcpf(1.f + __expf(-bflo(a.y))); r[3] = (1.f + __expf(-bfhi(bb.y))) * __builtin_amdgcn_rcpf(1.f + __expf(-bfhi(a.y)));
                        acc[ai][bj][m][n] *= r;
                    }
        }
    }
    __device__ __forceinline__ void operator()(const AccT& acc, const Unit& u, int wr, int wc, int fr, int fq) const {
#pragma unroll
        for (int ai = 0; ai < 2; ++ai) {
            uint2 gb[4][2][2];
#pragma unroll
            for (int m = 0; m < 4; ++m)
#pragma unroll
                for (int bj = 0; bj < 2; ++bj) {
                    const int row = u.pm * 256 + ai * 128 + wr * 64 + m * 16 + fr, cb = u.pn * 256 + bj * 128 + wc * 32;
                    const bf16_t* gp = proj + (size_t)row * PROJ_LD + 6144 + cb + 4 * fq;
                    { const u32x2 t0 = __builtin_nontemporal_load((const u32x2*)gp), t1 = __builtin_nontemporal_load((const u32x2*)(gp + 16)); gb[m][bj][0] = (uint2){t0.x, t0.y}; gb[m][bj][1] = (uint2){t1.x, t1.y}; }
                }
#pragma unroll
            for (int m = 0; m < 4; ++m)
#pragma unroll
                for (int bj = 0; bj < 2; ++bj) {
                    const int row = u.pm * 256 + ai * 128 + wr * 64 + m * 16 + fr, cb = u.pn * 256 + bj * 128 + wc * 32;
                    const f32x4 v0 = acc[ai][bj][m][0], v1 = acc[ai][bj][m][1];
                    const uint2 g0 = gb[m][bj][0], g1 = gb[m][bj][1];
                    f32x4 a, b;
                    a[0] = v0[0] * sigmoidf_(bflo(g0.x)); a[1] = v0[1] * sigmoidf_(bfhi(g0.x)); a[2] = v0[2] * sigmoidf_(bflo(g0.y)); a[3] = v0[3] * sigmoidf_(bfhi(g0.y));
                    b[0] = v1[0] * sigmoidf_(bflo(g1.x)); b[1] = v1[1] * sigmoidf_(bfhi(g1.x)); b[2] = v1[2] * sigmoidf_(bflo(g1.y)); b[3] = v1[3] * sigmoidf_(bfhi(g1.y));
                    bf16_t* p = Mo + (size_t)row * DM + cb + 4 * fq;
                    uint2 o0, o1; o0.x = cvt_pk_bf16(a[0], a[1]); o0.y = cvt_pk_bf16(a[2], a[3]); o1.x = cvt_pk_bf16(b[0], b[1]); o1.y = cvt_pk_bf16(b[2], b[3]);
                    *(uint2*)p = o0; *(uint2*)(p + 16) = o1;
                }
        }
    }
};

template <class Epi>
__device__ __forceinline__ void run_gemm(unsigned char* lds, const bf16_t* A, const bf16_t* Bt, int M, int N, int K, const Epi& E, int split = 1, const bf16_t* A1 = nullptr, const bf16_t* Bt1 = nullptr) {
    pg8::Gemm g{A, Bt, M, N, K, A1 ? A1 : A, Bt1 ? Bt1 : Bt};
    pg8::StaticOrder S; S.init(M, N, K, gridDim.x, blockIdx.x, split, A1 ? 2 : 1);
    pg8::gemm_phase<Epi>((LAS unsigned char*)lds, g, S, E);
    __syncthreads();
}

constexpr int CNT = 4;
__device__ __forceinline__ void conv_tile(float* tl, const float* __restrict__ src, int K, int N, bf16_t* dst, int mode, int nt, int kt) {
    const int tid = threadIdx.x;
    const int nl = tid & 63, k8 = tid >> 6;
    float v[CNT][8];
#pragma unroll
    for (int s2 = 0; s2 < CNT; ++s2) {
        const int np = (nt * CNT + s2) * 64 + nl;
        int j = np;
        if (mode == 1) { const int blk = np >> 5, r = np & 31; j = blk * 16 + (r & 15) + ((r >> 4) ? DFF : 0); }
        const bool valid = j < N;
#pragma unroll
        for (int i = 0; i < 8; ++i) {
            const int k = kt * 64 + k8 + 8 * i;
            v[s2][i] = valid ? __builtin_nontemporal_load(&src[(size_t)k * N + j]) : 0.f;
        }
    }
#pragma unroll
    for (int s2 = 0; s2 < CNT; ++s2)
#pragma unroll
        for (int i = 0; i < 8; ++i) tl[s2 * 64 * 65 + (k8 + 8 * i) * 65 + nl] = v[s2][i];
    __syncthreads();
    const int n2 = tid >> 3, kc = (tid & 7) * 8;
#pragma unroll
    for (int s2 = 0; s2 < CNT; ++s2) {
        const float* t2 = tl + s2 * 64 * 65;
        uint4 o;
        o.x = cvt_pk_bf16(t2[(kc + 0) * 65 + n2], t2[(kc + 1) * 65 + n2]);
        o.y = cvt_pk_bf16(t2[(kc + 2) * 65 + n2], t2[(kc + 3) * 65 + n2]);
        o.z = cvt_pk_bf16(t2[(kc + 4) * 65 + n2], t2[(kc + 5) * 65 + n2]);
        o.w = cvt_pk_bf16(t2[(kc + 6) * 65 + n2], t2[(kc + 7) * 65 + n2]);
        *(uint4*)(dst + (size_t)((nt * CNT + s2) * 64 + n2) * K + kt * 64 + kc) = o;
    }
    __syncthreads();
}
__device__ __forceinline__ void conv_job(float* tl, int& base, const float* src, int K, int N, bf16_t* dst, int nrows, int mode, int bidx = -1, int nblk = 0) {
    if (bidx < 0) { bidx = blockIdx.x; nblk = gridDim.x; }
    const int kts = K / 64, ntile = (nrows / (64 * CNT)) * kts;
    int first = bidx - (base % nblk); if (first < 0) first += nblk;
    for (int t = first; t < ntile; t += nblk) conv_tile(tl, src, K, N, dst, mode, t / kts, t % kts);
    base += ntile;
}

__device__ __forceinline__ void ada_item(const Params& p, float* lds, int item) {
    const int tid = threadIdx.x, w = tid >> 6, lane = tid & 63;
    const int nc = item % 72, ks = item / 72;
    float* sc = lds;
    float* red = lds + 5 * 512;
    for (int i = tid; i < 5 * 512; i += 512) {
        const int r = i / 512, k = ks * 512 + (i % 512);
        const float v = r == 0 ? p.c_ctx[k] : p.c[(r - 1) * DM + k];
        sc[i] = siluf_(v);
    }
    __syncthreads();
    float acc[5][4];
#pragma unroll
    for (int r = 0; r < 5; ++r)
#pragma unroll
        for (int j = 0; j < 4; ++j) acc[r][j] = 0.f;
    const float* wp = p.w_ada + (size_t)(ks * 512 + w * 64) * 18432 + nc * 256 + lane * 4;
#pragma unroll 8
    for (int kk = 0; kk < 64; ++kk) {
        const f32x4 wv = __builtin_nontemporal_load((const f32x4*)(wp + (size_t)kk * 18432));
#pragma unroll
        for (int r = 0; r < 5; ++r) {
            const float s = sc[r * 512 + w * 64 + kk];
#pragma unroll
            for (int j = 0; j < 4; ++j) acc[r][j] += s * wv[j];
        }
    }
#pragma unroll
    for (int r = 0; r < 5; ++r) *(f32x4*)(red + (w * 5 + r) * 256 + lane * 4) = (f32x4){acc[r][0], acc[r][1], acc[r][2], acc[r][3]};
    __syncthreads();
    float* modp = (float*)(p.ws + WS_MODP);
    for (int i = tid; i < 5 * 256; i += 512) {
        const int r = i / 256, cidx = i % 256;
        float s = 0.f;
#pragma unroll
        for (int ww = 0; ww < 8; ++ww) s += red[(ww * 5 + r) * 256 + cidx];
        modp[(size_t)(ks * 5 + r) * 18432 + nc * 256 + cidx] = s;
    }
    __syncthreads();
}

__device__ __forceinline__ void row_phase(const Params& p, int mode) {
    const int w = threadIdx.x >> 6, lane = threadIdx.x & 63;
    const float* mod = (const float*)(p.ws + WS_MOD);
    float* XR = p.out + OUT_Y;
    const bf16_t* Y = (const bf16_t*)(p.ws + WS_R2);
    const bf16_t* Y1 = (const bf16_t*)(p.ws + WS_Y1);
    bf16_t* H = (bf16_t*)(p.ws + WS_H);
    for (int row = blockIdx.x * 8 + w; row < TT; row += gridDim.x * 8) {
        const int mr = row < NCTX ? 0 : 1 + ((row - NCTX) >> 11);
        const float* mrow = mod + (size_t)mr * 18432;
        const float* xin = (mode <= 2) ? (row < NCTX ? p.x_prompt + (size_t)row * DM : p.x_sample + (size_t)(row - NCTX) * DM) : XR + (size_t)row * DM;
        f32x4 xv[8];
#pragma unroll
        for (int i = 0; i < 8; ++i) xv[i] = __builtin_nontemporal_load((const f32x4*)(xin + lane * 4 + 256 * i));
        if (mode >= 2) {
            const int gi = mode == 2 ? 2 : (mode == 3 ? 5 : 8), ni = mode == 2 ? 1 : (mode == 3 ? 3 : 5);
            const float coef = mode == 3 ? 1.f : 0.5f;
            f32x4 yv[8]; float ss = 0.f;
#pragma unroll
            for (int i = 0; i < 8; ++i) { const u32x2 ya = __builtin_nontemporal_load((const u32x2*)(Y + (size_t)row * DM + lane * 4 + 256 * i)), yb = __builtin_nontemporal_load((const u32x2*)(Y1 + (size_t)row * DM + lane * 4 + 256 * i));
                yv[i] = (f32x4){bflo(ya.x) + bflo(yb.x), bfhi(ya.x) + bfhi(yb.x), bflo(ya.y) + bflo(yb.y), bfhi(ya.y) + bfhi(yb.y)}; ss += yv[i][0] * yv[i][0] + yv[i][1] * yv[i][1] + yv[i][2] * yv[i][2] + yv[i][3] * yv[i][3]; }
            ss = wave_sum(ss);
            const float r = rsqrtf(ss * (1.f / DM) + 1e-6f);
#pragma unroll
            for (int i = 0; i < 8; ++i) {
                const f32x4 gt = *(const f32x4*)(mrow + gi * DM + lane * 4 + 256 * i);
                const f32x4 gn = *(const f32x4*)(p.norm_gains + ni * DM + lane * 4 + 256 * i);
#pragma unroll
                for (int j = 0; j < 4; ++j) xv[i][j] += coef * gt[j] * (yv[i][j] * r * gn[j]);
                if (mode == 4) __builtin_nontemporal_store(xv[i], (f32x4*)(XR + (size_t)row * DM + lane * 4 + 256 * i)); else *(f32x4*)(XR + (size_t)row * DM + lane * 4 + 256 * i) = xv[i];
            }
        }
        if (mode <= 3) {
            const int ni = mode == 1 ? 0 : (mode == 2 ? 2 : 4), shi = mode == 1 ? 0 : (mode == 2 ? 3 : 6);
            float ss = 0.f;
#pragma unroll
            for (int i = 0; i < 8; ++i) ss += xv[i][0] * xv[i][0] + xv[i][1] * xv[i][1] + xv[i][2] * xv[i][2] + xv[i][3] * xv[i][3];
            ss = wave_sum(ss);
            const float r = rsqrtf(ss * (1.f / DM) + 1e-6f);
#pragma unroll
            for (int i = 0; i < 8; ++i) {
                const f32x4 sh = *(const f32x4*)(mrow + shi * DM + lane * 4 + 256 * i);
                const f32x4 sc = *(const f32x4*)(mrow + (shi + 1) * DM + lane * 4 + 256 * i);
                const f32x4 gn = *(const f32x4*)(p.norm_gains + ni * DM + lane * 4 + 256 * i);
                float h[4];
#pragma unroll
                for (int j = 0; j < 4; ++j) h[j] = xv[i][j] * r * gn[j] * (1.f + sc[j]) + sh[j];
                uint2 o; o.x = cvt_pk_bf16(h[0], h[1]); o.y = cvt_pk_bf16(h[2], h[3]);
                *(uint2*)(H + (size_t)row * DM + lane * 4 + 256 * i) = o;
            }
        }
    }
}

__device__ __forceinline__ void token_phase(const Params& p) {
    const int w = threadIdx.x >> 6, lane = threadIdx.x & 63;
    const float* small = (const float*)(p.ws + WS_SMALL);
    const float* rope = (const float*)(p.ws + WS_ROPE);
    bf16_t* CQN = (bf16_t*)(p.ws + WS_CQN);
    bf16_t* CKVA = (bf16_t*)(p.ws + WS_CKVA);
    bf16_t* KRA = (bf16_t*)(p.ws + WS_KRA);
    for (int kr = blockIdx.x * 8 + w; kr < KVR; kr += gridDim.x * 8) {
        int tok = -1, bidx = 0, pp = 0;
        if (kr < NCTX) tok = kr;
        else { bidx = (kr - NCTX) / 2304; pp = (kr - NCTX) % 2304; if (pp >= 256) tok = NCTX + bidx * 2048 + (pp - 256); }
        if (tok < 0) {
            const float* s = p.cache_ckv + ((size_t)bidx * 256 + pp) * 512 + lane * 8;
            const f32x4 a = *(const f32x4*)s, b = *(const f32x4*)(s + 4);
            uint4 o; o.x = cvt_pk_bf16(a[0], a[1]); o.y = cvt_pk_bf16(a[2], a[3]); o.z = cvt_pk_bf16(b[0], b[1]); o.w = cvt_pk_bf16(b[2], b[3]);
            *(uint4*)(CKVA + (size_t)kr * 512 + lane * 8) = o;
            KRA[(size_t)kr * 64 + lane] = f2bf(p.cache_krope[((size_t)bidx * 256 + pp) * 64 + lane]);
            continue;
        }
        const float* srow = small + (size_t)tok * SMALL_LD;
        if (lane < 32) ((float*)(p.ws + WS_ACMP))[(size_t)tok * 32 + lane] = srow[lane];
        {
            const f32x4 a = __builtin_nontemporal_load((const f32x4*)(srow + 32 + lane * 8)), b = __builtin_nontemporal_load((const f32x4*)(srow + 36 + lane * 8));
            float ss = a[0] * a[0] + a[1] * a[1] + a[2] * a[2] + a[3] * a[3] + b[0] * b[0] + b[1] * b[1] + b[2] * b[2] + b[3] * b[3];
            ss = wave_sum(ss);
            const float r = rsqrtf(ss * (1.f / 512.f) + 1e-6f);
            const f32x4 g0 = *(const f32x4*)(p.q_norm + lane * 8), g1 = *(const f32x4*)(p.q_norm + lane * 8 + 4);
            uint4 o; o.x = cvt_pk_bf16(a[0] * r * g0[0], a[1] * r * g0[1]); o.y = cvt_pk_bf16(a[2] * r * g0[2], a[3] * r * g0[3]);
            o.z = cvt_pk_bf16(b[0] * r * g1[0], b[1] * r * g1[1]); o.w = cvt_pk_bf16(b[2] * r * g1[2], b[3] * r * g1[3]);
            *(uint4*)(CQN + (size_t)tok * 512 + lane * 8) = o;
        }
        {
            const f32x4 a = __builtin_nontemporal_load((const f32x4*)(srow + 544 + lane * 8)), b = __builtin_nontemporal_load((const f32x4*)(srow + 548 + lane * 8));
            float ss = a[0] * a[0] + a[1] * a[1] + a[2] * a[2] + a[3] * a[3] + b[0] * b[0] + b[1] * b[1] + b[2] * b[2] + b[3] * b[3];
            ss = wave_sum(ss);
            const float r = rsqrtf(ss * (1.f / 512.f) + 1e-6f);
            const f32x4 g0 = *(const f32x4*)(p.kv_norm + lane * 8), g1 = *(const f32x4*)(p.kv_norm + lane * 8 + 4);
            f32x4 ya, yb;
#pragma unroll
            for (int j = 0; j < 4; ++j) { ya[j] = a[j] * r * g0[j]; yb[j] = b[j] * r * g1[j]; }
            uint4 o; o.x = cvt_pk_bf16(ya[0], ya[1]); o.y = cvt_pk_bf16(ya[2], ya[3]); o.z = cvt_pk_bf16(yb[0], yb[1]); o.w = cvt_pk_bf16(yb[2], yb[3]);
            *(uint4*)(CKVA + (size_t)kr * 512 + lane * 8) = o;
            if (tok < NCTX) { float* op = p.out + OUT_CKV + (size_t)tok * 512 + lane * 8; __builtin_nontemporal_store(ya, (f32x4*)op); __builtin_nontemporal_store(yb, (f32x4*)(op + 4)); }
        }
        {
            const float v = srow[1056 + lane];
            if (tok < NCTX) { p.out[OUT_KROPE + (size_t)tok * 64 + lane] = v; KRA[(size_t)kr * 64 + lane] = f2bf(v); }
            else {
                const float pv = __shfl_xor(v, 16);
                const int it = (tok - NCTX) & 2047, axis = lane >> 5, half = (lane >> 4) & 1, fi = lane & 15;
                const int pos = axis == 0 ? (it >> 6) : (it & 63);
                const float cs = rope[(pos * 16 + fi) * 2], sn = rope[(pos * 16 + fi) * 2 + 1];
                const float o = half == 0 ? v * cs - pv * sn : v * cs + pv * sn;
                KRA[(size_t)kr * 64 + lane] = f2bf(o);
            }
        }
    }
}

__device__ __forceinline__ void gla_post_phase(const Params& p) {
    const int w = threadIdx.x >> 6, lane = threadIdx.x & 63;
    const bf16_t* OF = (const bf16_t*)(p.ws + WS_R2);
    const bf16_t* OB = OF + (size_t)TT * DM;
    const bf16_t* proj = (const bf16_t*)(p.ws + WS_R1);
    bf16_t* OG = (bf16_t*)(p.ws + WS_Q);
    const f32x4 gn0 = *(const f32x4*)(p.gla_norm + lane * 8), gn1 = *(const f32x4*)(p.gla_norm + lane * 8 + 4);
    for (int row = blockIdx.x * 8 + w; row < TT; row += gridDim.x * 8) {
#pragma unroll
        for (int h = 0; h < 4; ++h) {
            const size_t off = (size_t)row * DM + h * 512 + lane * 8;
            const u32x4 a = __builtin_nontemporal_load((const u32x4*)(OF + off)), b = __builtin_nontemporal_load((const u32x4*)(OB + off));
            const u32x4 rg = __builtin_nontemporal_load((const u32x4*)(proj + (size_t)row * PROJ_LD + 2048 + h * 512 + lane * 8));
            float o[8], g[8];
            o[0] = bflo(a.x) + bflo(b.x); o[1] = bfhi(a.x) + bfhi(b.x); o[2] = bflo(a.y) + bflo(b.y); o[3] = bfhi(a.y) + bfhi(b.y);
            o[4] = bflo(a.z) + bflo(b.z); o[5] = bfhi(a.z) + bfhi(b.z); o[6] = bflo(a.w) + bflo(b.w); o[7] = bfhi(a.w) + bfhi(b.w);
            g[0] = bflo(rg.x); g[1] = bfhi(rg.x); g[2] = bflo(rg.y); g[3] = bfhi(rg.y); g[4] = bflo(rg.z); g[5] = bfhi(rg.z); g[6] = bflo(rg.w); g[7] = bfhi(rg.w);
            float ss = 0.f;
#pragma unroll
            for (int j = 0; j < 8; ++j) ss += o[j] * o[j];
            ss = wave_sum(ss);
            const float r = rsqrtf(ss * (1.f / 512.f) + 1e-6f);
            float y[8];
#pragma unroll
            for (int j = 0; j < 8; ++j) y[j] = o[j] * r * (j < 4 ? gn0[j] : gn1[j - 4]) * siluf_(g[j]);
            uint4 ov; ov.x = cvt_pk_bf16(y[0], y[1]); ov.y = cvt_pk_bf16(y[2], y[3]); ov.z = cvt_pk_bf16(y[4], y[5]); ov.w = cvt_pk_bf16(y[6], y[7]);
            *(uint4*)(OG + off) = ov;
        }
    }
}

__device__ __forceinline__ void attn_item(const Params& p, unsigned char* ldsb, int s, int h, int qb) {
    int tid = threadIdx.x; asm volatile("" : "+v"(tid));
    const int w = tid >> 6, lane = tid & 63, lr = lane & 15, g = lane >> 4;
    int tok0, kr0, nkv;
    if (s < 16) { tok0 = s * 256; kr0 = s * 256; nkv = 256; } else { const int b = s - 16; tok0 = NCTX + b * 2048 + qb * 256; kr0 = NCTX + b * 2304; nkv = 2304; }
    const bf16_t* Q = (const bf16_t*)(p.ws + WS_Q);
    const bf16_t* KN = (const bf16_t*)(p.ws + WS_KN);
    const bf16_t* VT = (const bf16_t*)(p.ws + WS_VT);
    const bf16_t* KR = (const bf16_t*)(p.ws + WS_KRA);
    bf16_t* OM = (bf16_t*)(p.ws + WS_OM);
    bf16_t* lds = (bf16_t*)ldsb;
    constexpr int KST = 200, VST = 72, STAGE = 64 * KST + 128 * VST;
    bf16x8 Bq[2][6];
#pragma unroll
    for (int qf = 0; qf < 2; ++qf)
#pragma unroll
        for (int ks = 0; ks < 6; ++ks) Bq[qf][ks] = *(const bf16x8*)(Q + (size_t)(tok0 + 32 * w + 16 * qf + lr) * 3072 + h * 192 + 32 * ks + 8 * g);
    f32x4 O[8][2];
#pragma unroll
    for (int df = 0; df < 8; ++df) { O[df][0] = (f32x4){0.f, 0.f, 0.f, 0.f}; O[df][1] = (f32x4){0.f, 0.f, 0.f, 0.f}; }
    float mrun[2] = {-1e30f, -1e30f}, lrun[2] = {0.f, 0.f}, mpend[2] = {-1e30f, -1e30f};
    const float cscale = 0.07216878364870322f * 1.4426950408889634f;
    uint4 rk0, rk1, rk2, rv0, rv1;
    const int nt = nkv / 64;
#define ATT_LK(i, dst, t) do { const int id = tid + 512 * (i), row = id / 24, c = id % 24; const size_t krw = (size_t)(kr0 + 64 * (t) + row); \
        const bf16_t* src = c < 16 ? KN + krw * 2048 + h * 128 + 8 * c : KR + krw * 64 + 8 * (c - 16); dst = *(const uint4*)src; } while (0)
#define ATT_LV(i, dst, t) do { const int id = tid + 512 * (i), dv = id >> 3, c = id & 7; dst = *(const uint4*)(VT + (size_t)(h * 128 + dv) * KVR + kr0 + 64 * (t) + 8 * c); } while (0)
#define ATT_LOAD(t) do { ATT_LK(0, rk0, t); ATT_LK(1, rk1, t); ATT_LK(2, rk2, t); ATT_LV(0, rv0, t); ATT_LV(1, rv1, t); } while (0)
#define ATT_SK(i, src_, Kb_) do { const int id = tid + 512 * (i), row = id / 24, c = id % 24; *(uint4*)((Kb_) + row * KST + 8 * c) = src_; } while (0)
#define ATT_SV(i, src_, Vb_) do { const int id = tid + 512 * (i), dv = id >> 3, c = id & 7; *(uint4*)((Vb_) + dv * VST + 8 * c) = src_; } while (0)
#define ATT_STORE(buf) do { bf16_t* Kb_ = lds + (buf) * STAGE; bf16_t* Vb_ = Kb_ + 64 * KST; ATT_SK(0, rk0, Kb_); ATT_SK(1, rk1, Kb_); ATT_SK(2, rk2, Kb_); ATT_SV(0, rv0, Vb_); ATT_SV(1, rv1, Vb_); } while (0)
    ATT_LOAD(0); ATT_STORE(0);
    __syncthreads();
    for (int t = 0; t < nt; ++t) {
        const bf16_t* Kb = lds + (t & 1) * STAGE; const bf16_t* Vb = Kb + 64 * KST;
        bf16_t* Kn = lds + ((t + 1) & 1) * STAGE; bf16_t* Vn = Kn + 64 * KST;
        const bool more = (t + 1 < nt);
        if (more) { ATT_LK(0, rk0, t + 1); ATT_LK(1, rk1, t + 1); ATT_LK(2, rk2, t + 1); }
        f32x4 st[4][2];
#pragma unroll
        for (int kf = 0; kf < 4; ++kf) { st[kf][0] = (f32x4){0.f, 0.f, 0.f, 0.f}; st[kf][1] = (f32x4){0.f, 0.f, 0.f, 0.f}; }
#pragma unroll
        for (int ks = 0; ks < 6; ++ks)
#pragma unroll
            for (int kf = 0; kf < 4; ++kf) {
                const bf16x8 a = *(const bf16x8*)(Kb + (16 * kf + lr) * KST + 32 * ks + 8 * g);
                st[kf][0] = __builtin_amdgcn_mfma_f32_16x16x32_bf16(a, Bq[0][ks], st[kf][0], 0, 0, 0);
                st[kf][1] = __builtin_amdgcn_mfma_f32_16x16x32_bf16(a, Bq[1][ks], st[kf][1], 0, 0, 0);
                if (kf & 1) __builtin_amdgcn_sched_barrier(0);
            }
        if (more) { ATT_SK(0, rk0, Kn); ATT_SK(1, rk1, Kn); ATT_SK(2, rk2, Kn); ATT_LV(0, rv0, t + 1); ATT_LV(1, rv1, t + 1); }
        bf16x8 Bp[2][2];
#pragma unroll
        for (int qf = 0; qf < 2; ++qf) {
            float mx = st[0][qf][0];
#pragma unroll
            for (int kf = 0; kf < 4; ++kf)
#pragma unroll
                for (int r = 0; r < 4; ++r) mx = fmaxf(mx, st[kf][qf][r]);
            mx = fmaxf(mx, __shfl_xor(mx, 16)); mx = fmaxf(mx, __shfl_xor(mx, 32));
            const float mnew = (t == 0) ? mx * cscale : fmaxf(mrun[qf], mpend[qf]);
            mpend[qf] = mx * cscale;
            const float alpha = __builtin_amdgcn_exp2f(mrun[qf] - mnew);
            mrun[qf] = mnew;
            float ps = 0.f; float pv[4][4];
#pragma unroll
            for (int kf = 0; kf < 4; ++kf)
#pragma unroll
                for (int r = 0; r < 4; ++r) { pv[kf][r] = __builtin_amdgcn_exp2f(st[kf][qf][r] * cscale - mnew); ps += pv[kf][r]; }
            lrun[qf] = lrun[qf] * alpha + ps;
#pragma unroll
            for (int df = 0; df < 8; ++df) O[df][qf] *= alpha;
#pragma unroll
            for (int s2 = 0; s2 < 2; ++s2) {
                union { bf16x8 v; unsigned u[4]; } pk;
                pk.u[0] = cvt_pk_bf16(pv[2 * s2][0], pv[2 * s2][1]); pk.u[1] = cvt_pk_bf16(pv[2 * s2][2], pv[2 * s2][3]);
                pk.u[2] = cvt_pk_bf16(pv[2 * s2 + 1][0], pv[2 * s2 + 1][1]); pk.u[3] = cvt_pk_bf16(pv[2 * s2 + 1][2], pv[2 * s2 + 1][3]);
                Bp[qf][s2] = pk.v;
            }
        }
#pragma unroll
        for (int s2 = 0; s2 < 2; ++s2)
#pragma unroll
            for (int df = 0; df < 8; ++df) {
                union { bf16x8 v; bf16x4 hh[2]; } a;
                a.hh[0] = *(const bf16x4*)(Vb + (16 * df + lr) * VST + 32 * s2 + 4 * g);
                a.hh[1] = *(const bf16x4*)(Vb + (16 * df + lr) * VST + 32 * s2 + 16 + 4 * g);
                O[df][0] = __builtin_amdgcn_mfma_f32_16x16x32_bf16(a.v, Bp[0][s2], O[df][0], 0, 0, 0);
                O[df][1] = __builtin_amdgcn_mfma_f32_16x16x32_bf16(a.v, Bp[1][s2], O[df][1], 0, 0, 0);
                if (df & 1) __builtin_amdgcn_sched_barrier(0);
            }
        if (more) { ATT_SV(0, rv0, Vn); ATT_SV(1, rv1, Vn); }
        __syncthreads();
    }
#undef ATT_LOAD
#undef ATT_STORE
#undef ATT_LK
#undef ATT_LV
#undef ATT_SK
#undef ATT_SV
    int tid2 = threadIdx.x; asm volatile("" : "+v"(tid2));
    const int w2 = tid2 >> 6, lr2 = tid2 & 15, g2 = (tid2 & 63) >> 4;
#pragma unroll
    for (int qf = 0; qf < 2; ++qf) {
        float l = lrun[qf]; l += __shfl_xor(l, 16); l += __shfl_xor(l, 32);
        const float inv = 1.f / l;
        bf16_t* op = OM + (size_t)(tok0 + 32 * w2 + 16 * qf + lr2) * DM + h * 128 + 4 * g2;
#pragma unroll
        for (int df = 0; df < 8; ++df) {
            uint2 o; o.x = cvt_pk_bf16(O[df][qf][0] * inv, O[df][qf][1] * inv); o.y = cvt_pk_bf16(O[df][qf][2] * inv, O[df][qf][3] * inv);
            *(uint2*)(op + 16 * df) = o;
        }
    }
}

__device__ __forceinline__ void gla_a_item(const Params& p, unsigned char* ldsb, int cg, int h, int dir) {
    int tid = threadIdx.x; asm volatile("" : "+v"(tid));
    const int w = tid >> 6, lane = tid & 63, lr = lane & 15, g = lane >> 4;
    const int c0 = cg * 64;
    const int it = (dir * 192 + cg) * 4 + h;
    const bf16_t* proj = (const bf16_t*)(p.ws + WS_R1);
    const bf16_t* VGT = (const bf16_t*)(p.ws + WS_VGT);
    const float* acmp = (const float*)(p.ws + WS_ACMP);
    bf16_t* OD = (bf16_t*)(p.ws + WS_R2) + (size_t)dir * TT * DM;
    bf16_t* QDg = (bf16_t*)(p.ws + WS_QD) + (size_t)it * 64 * 256;
    bf16_t* KITg = (bf16_t*)(p.ws + WS_KIT) + (size_t)it * 64 * 256;
    float* DECg = (float*)(p.ws + WS_DEC) + (size_t)it * 256;
    constexpr int QST = 264, TST = 72;
    bf16_t* qd = (bf16_t*)ldsb;
    bf16_t* kk = qd + 64 * QST;
    bf16_t* kinvT = kk + 64 * QST;
    bf16_t* vT = kinvT + 256 * TST;
    bf16_t* Amat = vT + 128 * TST;
    bf16_t* aop = Amat + 64 * TST;
    float* decay = (float*)(aop + 64 * TST);
    {
        uint4 rq0, rq1, rq2, rq3, rk0, rk1, rk2, rk3; f32x4 ra = (f32x4){0.f, 0.f, 0.f, 0.f};
#define GA_LQK(i, dq, dk) do { const int id = tid + 512 * (i), ir = id >> 5, c = id & 31; const size_t tok = (size_t)(c0 + (dir ? 63 - ir : ir)); \
        dq = *(const uint4*)(proj + tok * PROJ_LD + h * 256 + 8 * c); dk = *(const uint4*)(proj + tok * PROJ_LD + 1024 + h * 256 + 8 * c); } while (0)
#define GA_SQK(i, sq, sk) do { const int id = tid + 512 * (i), ir = id >> 5, c = id & 31; *(uint4*)(qd + ir * QST + 8 * c) = sq; *(uint4*)(kk + ir * QST + 8 * c) = sk; } while (0)
        GA_LQK(0, rq0, rk0); GA_LQK(1, rq1, rk1); GA_LQK(2, rq2, rk2); GA_LQK(3, rq3, rk3);
        if (tid < 256) { const int ir = tid >> 2, r4 = tid & 3; ra = *(const f32x4*)(acmp + (size_t)(c0 + (dir ? 63 - ir : ir)) * 32 + dir * 16 + 4 * r4); }
        GA_SQK(0, rq0, rk0); GA_SQK(1, rq1, rk1); GA_SQK(2, rq2, rk2); GA_SQK(3, rq3, rk3);
#undef GA_LQK
#undef GA_SQK
        if (tid < 256) {
            const int ir = tid >> 2, r4 = tid & 3;
            uint2 hv, lv;
            hv.x = cvt_pk_bf16(ra[0], ra[1]); hv.y = cvt_pk_bf16(ra[2], ra[3]);
            lv.x = cvt_pk_bf16(ra[0] - bflo(hv.x), ra[1] - bfhi(hv.x)); lv.y = cvt_pk_bf16(ra[2] - bflo(hv.y), ra[3] - bfhi(hv.y));
            bf16_t* ap = aop + ir * TST + 4 * r4;
            *(uint2*)ap = hv; *(uint2*)(ap + 16) = lv; *(uint2*)(ap + 32) = hv; *(uint2*)(ap + 48) = (uint2){0u, 0u};
        }
    }
    __syncthreads();
#pragma unroll
    for (int kfi = 0; kfi < 2; ++kfi) {
        const int k = 16 * (2 * w + kfi) + lr;
        bf16x8 Wb0, Wb1;
        {
            union { bf16x8 v; unsigned u[4]; } hi, lo;
#pragma unroll
            for (int j2 = 0; j2 < 4; ++j2) {
                const float w0 = p.w_gla_alpha[((size_t)dir * 16 + ((8 * g + 2 * j2) & 15)) * 1024 + h * 256 + k];
                const float w1 = p.w_gla_alpha[((size_t)dir * 16 + ((8 * g + 2 * j2 + 1) & 15)) * 1024 + h * 256 + k];
                const unsigned hu = cvt_pk_bf16(w0, w1);
                hi.u[j2] = hu;
                lo.u[j2] = (g < 2) ? cvt_pk_bf16(w0 - bflo(hu), w1 - bfhi(hu)) : 0u;
            }
            Wb0 = hi.v; Wb1 = lo.v;
        }
        const float bias = p.b_gla_alpha[(size_t)dir * 1024 + h * 256 + k];
        f32x4 la[4];
#pragma unroll
        for (int tf = 0; tf < 4; ++tf) {
            f32x4 a = (f32x4){0.f, 0.f, 0.f, 0.f};
            a = __builtin_amdgcn_mfma_f32_16x16x32_bf16(*(const bf16x8*)(aop + (16 * tf + lr) * TST + 8 * g), Wb0, a, 0, 0, 0);
            a = __builtin_amdgcn_mfma_f32_16x16x32_bf16(*(const bf16x8*)(aop + (16 * tf + lr) * TST + 32 + 8 * g), Wb1, a, 0, 0, 0);
#pragma unroll
            for (int r = 0; r < 4; ++r) { const float x = a[r] + bias; la[tf][r] = (fminf(x, 0.f) - __logf(1.f + __expf(-fabsf(x)))) * (1.f / 16.f); }
        }
        float run = 0.f;
#pragma unroll
        for (int tf = 0; tf < 4; ++tf) {
            la[tf][1] += la[tf][0]; la[tf][2] += la[tf][1]; la[tf][3] += la[tf][2];
            const float tot = la[tf][3];
            const float t0 = __shfl(tot, lr), t1 = __shfl(tot, lr + 16), t2 = __shfl(tot, lr + 32), t3 = __shfl(tot, lr + 48);
            const float off = run + (g > 0 ? t0 : 0.f) + (g > 1 ? t1 : 0.f) + (g > 2 ? t2 : 0.f);
#pragma unroll
            for (int r = 0; r < 4; ++r) la[tf][r] += off;
            run += t0 + t1 + t2 + t3;
        }
        if (g == 3) { const float d = __expf(la[3][3]); decay[k] = d; DECg[k] = d; }
#pragma unroll
        for (int tf = 0; tf < 4; ++tf) {
            float ki[4];
#pragma unroll
            for (int r = 0; r < 4; ++r) {
                const int i = 16 * tf + 4 * g + r;
                const float b = la[tf][r];
                const float qv = bf2f(qd[i * QST + k]) * __expf(b) * (1.f / 16.f);
                ki[r] = bf2f(kk[i * QST + k]) * __expf(-b);
                qd[i * QST + k] = f2bf(qv);
                kk[i * QST + k] = f2bf(ki[r]);
            }
            uint2 o; o.x = cvt_pk_bf16(ki[0], ki[1]); o.y = cvt_pk_bf16(ki[2], ki[3]);
            *(uint2*)(kinvT + k * TST + 16 * tf + 4 * g) = o;
        }
    }
    __syncthreads();
#pragma unroll
    for (int ff = 0; ff < 2; ++ff) {
        const int f = 2 * w + ff, jf = f >> 2, iff = f & 3;
        f32x4 a = (f32x4){0.f, 0.f, 0.f, 0.f};
        if (jf <= iff) {
#pragma unroll
            for (int ks = 0; ks < 8; ++ks)
                a = __builtin_amdgcn_mfma_f32_16x16x32_bf16(*(const bf16x8*)(kk + (16 * jf + lr) * QST + 32 * ks + 8 * g), *(const bf16x8*)(qd + (16 * iff + lr) * QST + 32 * ks + 8 * g), a, 0, 0, 0);
            if (jf == iff) {
#pragma unroll
                for (int r = 0; r < 4; ++r) if (4 * g + r > lr) a[r] = 0.f;
            }
        }
        uint2 o; o.x = cvt_pk_bf16(a[0], a[1]); o.y = cvt_pk_bf16(a[2], a[3]);
        *(uint2*)(Amat + (16 * iff + lr) * TST + 16 * jf + 4 * g) = o;
    }
#pragma unroll
    for (int i = 0; i < 4; ++i) {
        const int id = tid + 512 * i;
        { const int ir = id >> 5, c = id & 31; *(uint4*)(QDg + (size_t)ir * 256 + 8 * c) = *(const uint4*)(qd + ir * QST + 8 * c); }
        { const int k = id >> 3, c = id & 7; *(uint4*)(KITg + (size_t)k * 64 + 8 * c) = *(const uint4*)(kinvT + k * TST + 8 * c); }
    }
    __syncthreads();
    {
        bf16_t* AMg = (bf16_t*)(p.ws + WS_AM) + (size_t)it * 4096;
        const int i = tid >> 3, c = tid & 7;
        *(uint4*)(AMg + i * 64 + 8 * c) = *(const uint4*)(Amat + i * TST + 8 * c);
    }
}

__device__ __forceinline__ void gla_b_unit(const Params& p, unsigned char* ldsb, int s, int h, int dir, int vs) {
    int tid0 = threadIdx.x; asm volatile("" : "+v"(tid0));
    const int w = tid0 >> 6, lane = tid0 & 63, lr = lane & 15, g = lane >> 4;
    const int nch = s < 16 ? 4 : 32;
    const int tb = s < 16 ? s * 256 : NCTX + (s - 16) * 2048;
    const bf16_t* VGT = (const bf16_t*)(p.ws + WS_VGT);
    const bf16_t* QDg = (const bf16_t*)(p.ws + WS_QD);
    const bf16_t* KITg = (const bf16_t*)(p.ws + WS_KIT);
    const float* DECg = (const float*)(p.ws + WS_DEC);
    const bf16_t* AMg = (const bf16_t*)(p.ws + WS_AM);
    bf16_t* OD = (bf16_t*)(p.ws + WS_R2) + (size_t)dir * TT * DM;
    constexpr int QST = 264, TST = 72;
    bf16_t* qd = (bf16_t*)ldsb;
    bf16_t* kinvT = qd + 64 * QST;
    bf16_t* vT = kinvT + 256 * TST;
    float* decay = (float*)(vT + 128 * TST);
    bf16_t* AmatL = (bf16_t*)(decay + 256);
    f32x4 S[16];
    const int vcol = vs * 128 + 16 * w + lr;
    if (s < 16) {
#pragma unroll
        for (int kf = 0; kf < 16; ++kf) S[kf] = (f32x4){0.f, 0.f, 0.f, 0.f};
    } else {
        const float* sp = (dir == 0 ? p.st_f : p.st_b) + ((size_t)((s - 16) * 4 + h) * 256) * 512 + vcol;
#pragma unroll
        for (int kf = 0; kf < 16; ++kf)
#pragma unroll
            for (int r = 0; r < 4; ++r) S[kf][r] = sp[(size_t)(16 * kf + 4 * g + r) * 512];
    }
    uint4 rq0, rq1, rq2, rq3, rk0, rk1, rk2, rk3, rv0, rv1, rm; float rd = 0.f;
#define GB_LOAD(ci_) do { int tid = threadIdx.x; asm volatile("" : "+v"(tid)); const int oc_ = dir ? nch - 1 - (ci_) : (ci_); const int c0_ = tb + oc_ * 64; const size_t it_ = (size_t)((dir * 192 + (c0_ >> 6)) * 4 + h); \
        rq0 = *(const uint4*)(QDg + it_ * 16384 + (size_t)(tid) * 8); rq1 = *(const uint4*)(QDg + it_ * 16384 + (size_t)(tid + 512) * 8); \
        rq2 = *(const uint4*)(QDg + it_ * 16384 + (size_t)(tid + 1024) * 8); rq3 = *(const uint4*)(QDg + it_ * 16384 + (size_t)(tid + 1536) * 8); \
        rk0 = *(const uint4*)(KITg + it_ * 16384 + (size_t)(tid) * 8); rk1 = *(const uint4*)(KITg + it_ * 16384 + (size_t)(tid + 512) * 8); \
        rk2 = *(const uint4*)(KITg + it_ * 16384 + (size_t)(tid + 1024) * 8); rk3 = *(const uint4*)(KITg + it_ * 16384 + (size_t)(tid + 1536) * 8); \
        { const int v = tid >> 3, c = tid & 7; rv0 = *(const uint4*)(VGT + (size_t)(h * 512 + vs * 128 + v) * TT + c0_ + 8 * c); rv1 = *(const uint4*)(VGT + (size_t)(h * 512 + vs * 128 + 64 + v) * TT + c0_ + 8 * c); } \
        rm = *(const uint4*)(AMg + it_ * 4096 + (size_t)tid * 8); \
        if (tid < 256) rd = DECg[it_ * 256 + tid]; } while (0)
#define GB_SQ(i, sq) do { const int id = tid + 512 * (i), ir = id >> 5, c = id & 31; *(uint4*)(qd + ir * QST + 8 * c) = sq; } while (0)
#define GB_SK(i, sk) do { const int id = tid + 512 * (i), k = id >> 3, c = id & 7; *(uint4*)(kinvT + k * TST + 8 * c) = sk; } while (0)
#define GB_SV(i, sv) do { const int id = tid + 512 * (i), v = id >> 3, c = id & 7; uint4 x = sv; \
        if (dir) { uint4 y; y.x = (x.w >> 16) | (x.w << 16); y.y = (x.z >> 16) | (x.z << 16); y.z = (x.y >> 16) | (x.y << 16); y.w = (x.x >> 16) | (x.x << 16); x = y; } \
        *(uint4*)(vT + v * TST + (dir ? 56 - 8 * c : 8 * c)) = x; } while (0)
    GB_LOAD(0);
    for (int ci = 0; ci < nch; ++ci) {
        const int oc = dir ? nch - 1 - ci : ci; const int c0 = tb + oc * 64;
        {
            int tid = threadIdx.x; asm volatile("" : "+v"(tid));
            GB_SQ(0, rq0); GB_SQ(1, rq1); GB_SQ(2, rq2); GB_SQ(3, rq3); GB_SK(0, rk0); GB_SK(1, rk1); GB_SK(2, rk2); GB_SK(3, rk3); GB_SV(0, rv0); GB_SV(1, rv1);
            *(uint4*)(AmatL + (tid >> 3) * TST + 8 * (tid & 7)) = rm;
            if (tid < 256) decay[tid] = rd;
        }
        __syncthreads();
        if (ci + 1 < nch) GB_LOAD(ci + 1);
        f32x4 oT[4];
#pragma unroll
        for (int iff = 0; iff < 4; ++iff) oT[iff] = (f32x4){0.f, 0.f, 0.f, 0.f};
#pragma unroll
        for (int s2 = 0; s2 < 8; ++s2) {
            union { bf16x8 v; unsigned u[4]; } sb;
            sb.u[0] = cvt_pk_bf16(S[2 * s2][0], S[2 * s2][1]); sb.u[1] = cvt_pk_bf16(S[2 * s2][2], S[2 * s2][3]);
            sb.u[2] = cvt_pk_bf16(S[2 * s2 + 1][0], S[2 * s2 + 1][1]); sb.u[3] = cvt_pk_bf16(S[2 * s2 + 1][2], S[2 * s2 + 1][3]);
#pragma unroll
            for (int iff = 0; iff < 4; ++iff) {
                union { bf16x8 v; bf16x4 hh[2]; } b;
                b.hh[0] = *(const bf16x4*)(qd + (16 * iff + lr) * QST + 32 * s2 + 4 * g);
                b.hh[1] = *(const bf16x4*)(qd + (16 * iff + lr) * QST + 32 * s2 + 16 + 4 * g);
                oT[iff] = __builtin_amdgcn_mfma_f32_16x16x32_bf16(sb.v, b.v, oT[iff], 0, 0, 0);
            }
            __builtin_amdgcn_sched_barrier(0);
        }
#pragma unroll
        for (int s2 = 0; s2 < 2; ++s2) {
            const bf16x8 a = *(const bf16x8*)(vT + (16 * w + lr) * TST + 32 * s2 + 8 * g);
#pragma unroll
            for (int iff = 0; iff < 4; ++iff)
                oT[iff] = __builtin_amdgcn_mfma_f32_16x16x32_bf16(a, *(const bf16x8*)(AmatL + (16 * iff + lr) * TST + 32 * s2 + 8 * g), oT[iff], 0, 0, 0);
        }
#pragma unroll
        for (int s2 = 0; s2 < 2; ++s2) {
            const bf16x8 b = *(const bf16x8*)(vT + (16 * w + lr) * TST + 32 * s2 + 8 * g);
#pragma unroll
            for (int kf = 0; kf < 16; ++kf)
            {
                S[kf] = __builtin_amdgcn_mfma_f32_16x16x32_bf16(*(const bf16x8*)(kinvT + (16 * kf + lr) * TST + 32 * s2 + 8 * g), b, S[kf], 0, 0, 0);
                if ((kf & 3) == 3) __builtin_amdgcn_sched_barrier(0);
            }
        }
#pragma unroll
        for (int kf = 0; kf < 16; ++kf) { const f32x4 d = *(const f32x4*)(decay + 16 * kf + 4 * g); S[kf] *= d; }
        asm volatile("s_waitcnt vmcnt(0)" ::: "memory");
#pragma unroll
        for (int iff = 0; iff < 4; ++iff) {
            const int i = 16 * iff + lr;
            const size_t tok = (size_t)(c0 + (dir ? 63 - i : i));
            uint2 o; o.x = cvt_pk_bf16(oT[iff][0], oT[iff][1]); o.y = cvt_pk_bf16(oT[iff][2], oT[iff][3]);
            *(uint2*)(OD + tok * DM + h * 512 + vs * 128 + 16 * w + 4 * g) = o;
        }
        __syncthreads();
    }
#undef GB_LOAD
#undef GB_SQ
#undef GB_SK
#undef GB_SV
    if (s < 16) {
        float* op = p.out + (dir == 0 ? OUT_SF : OUT_SB) + ((size_t)(s * 4 + h) * 256) * 512 + vcol;
#pragma unroll
        for (int kf = 0; kf < 16; ++kf)
#pragma unroll
            for (int r = 0; r < 4; ++r) op[(size_t)(16 * kf + 4 * g + r) * 512] = S[kf][r];
    }
}

__device__ __forceinline__ int queue_pop(const Params& p, unsigned char* lds, int q) {
    unsigned* cnt = (unsigned*)(p.ws + WS_CNT) + q;
    int* slot = (int*)(lds + LDS_BYTES - 16);
    __syncthreads();
    if (threadIdx.x == 0) *slot = (int)atomicAdd(cnt, 1u);
    __syncthreads();
    return *slot;
}
__device__ __forceinline__ void gla_a_phase(const Params& p, unsigned char* lds, int qi) {
    (void)qi;
    for (int it = blockIdx.x; it < 1536; it += gridDim.x) {
        __syncthreads();
        gla_a_item(p, lds, it >> 3, (it >> 1) & 3, it & 1);
    }
}
__device__ __forceinline__ void gla_b_phase(const Params& p, unsigned char* lds, int qi) {
    for (;;) {
        const int it = queue_pop(p, lds, qi);
        if (it >= 640) break;
        int s, h, dir, vs;
        if (it < 128) { s = 16 + (it >> 5); h = (it >> 3) & 3; dir = (it >> 2) & 1; vs = it & 3; }
        else { const int u = it - 128; s = u >> 5; h = (u >> 3) & 3; dir = (u >> 2) & 1; vs = u & 3; }
        gla_b_unit(p, lds, s, h, dir, vs);
    }
    for (;;) {
        const int t = queue_pop(p, lds, qi + 1);
        if (t >= 768) break;
        const int j = t >> 8, tt = t & 255;
        const float* src = j == 0 ? p.w_gla_out : (j == 1 ? p.w_mla_out : p.w_out);
        bf16_t* dst = (bf16_t*)(p.ws + (j == 0 ? WS_WT_G : (j == 1 ? WS_WT_M : WS_WT_OUT)));
        conv_tile((float*)lds, src, 2048, 2048, dst, 0, tt >> 5, tt & 31);
    }
}
__device__ __forceinline__ void attn_phase(const Params& p, unsigned char* lds, int qi = 1) {
    for (;;) {
        const int it = queue_pop(p, lds, qi);
        if (it >= 768) break;
        int s, h, qb;
        if (it < 512) { s = 16 + (it >> 7); h = (it >> 3) & 15; qb = it & 7; }
        else { const int u = it - 512; s = u >> 4; h = u & 15; qb = 0; }
        attn_item(p, lds, s, h, qb);
    }
}

#define XB_TMO      128
#define XB_XCNT(j)  (256  + 64 * (j))
#define XB_XSUB(j)  (1280 + 64 * (j))
#define XB_XGEN(j)  (2304 + 64 * (j))
#define XB_TOP      3328
#define XB_TOPGEN   3392
#define XCD_BAR_WORDS 3456
#define XB_SPIN_CAP (1u << 22)
__device__ __forceinline__ unsigned xb_ld(unsigned* p)              { return __hip_atomic_load(p, __ATOMIC_RELAXED, __HIP_MEMORY_SCOPE_AGENT); }
__device__ __forceinline__ unsigned xb_add(unsigned* p, unsigned v) { return __hip_atomic_fetch_add(p, v, __ATOMIC_RELAXED, __HIP_MEMORY_SCOPE_AGENT); }
__device__ __forceinline__ unsigned xb_xcc_id() { return (unsigned)__builtin_amdgcn_s_getreg((3 << 11) | 20) & 0xFu; }
#define XB_SPIN(cond, bar) do { unsigned _sp = 0; while (cond) { __builtin_amdgcn_s_sleep(1); \
    if ((++_sp & 255u) == 0u) { if (xb_ld(&(bar)[XB_TMO])) break; if (_sp > XB_SPIN_CAP) { atomicAdd(&(bar)[XB_TMO], 1u); break; } } } } while (0)
struct XcdBarrier { unsigned* bar; unsigned x; volatile LAS unsigned* st; };
__device__ __forceinline__ XcdBarrier xcd_barrier_post(unsigned* bar, volatile LAS unsigned* st) {
    XcdBarrier b; b.bar = bar; b.x = xb_xcc_id(); b.st = st;
    if (threadIdx.x == 0) (void)xb_add(&bar[XB_XCNT(b.x)], 1u);
    return b;
}
__device__ __forceinline__ void xcd_barrier_complete(unsigned* bar, unsigned x, unsigned& nloc, unsigned& nx) {
    const unsigned G = gridDim.x * gridDim.y * gridDim.z;
    unsigned sum, cnt, mine, sp = 0u;
    for (;;) {
        sum = 0u; cnt = 0u; mine = 0u;
#pragma unroll
        for (unsigned j = 0; j < 16; ++j) { const unsigned c = xb_ld(&bar[XB_XCNT(j)]); sum += c; cnt += (c > 0u) ? 1u : 0u; mine = (j == x) ? c : mine; }
        if (sum == G) break;
        __builtin_amdgcn_s_sleep(1);
        if ((++sp & 255u) == 0u) { if (xb_ld(&bar[XB_TMO])) break; if (sp > XB_SPIN_CAP) { atomicAdd(&bar[XB_TMO], 1u); break; } }
    }
    nloc = mine > 0u ? mine : 1u; nx = cnt > 0u ? cnt : 1u;
}
__device__ __forceinline__ void xcd_barrier(const XcdBarrier& b) {
    asm volatile("s_waitcnt vmcnt(0)" ::: "memory");
    __syncthreads();
    if (threadIdx.x == 0) {
        unsigned* bar = b.bar;
        __builtin_amdgcn_s_waitcnt(0);
        unsigned nloc = b.st[0], nx = b.st[1];
        if (nloc == 0u) { xcd_barrier_complete(bar, b.x, nloc, nx); b.st[0] = nloc; b.st[1] = nx; }
        const unsigned old = xb_add(&bar[XB_XSUB(b.x)], 1u);
        const unsigned gen = old / nloc;
        if (old + 1u == (gen + 1u) * nloc) {
            __builtin_amdgcn_fence(__ATOMIC_RELEASE, "agent");
            asm volatile("s_waitcnt vmcnt(0)" ::: "memory");
            const unsigned og = xb_add(&bar[XB_TOP], 1u);
            const unsigned tg = og / nx;
            if (og + 1u == (tg + 1u) * nx) xb_add(&bar[XB_TOPGEN], 1u);
            else XB_SPIN(xb_ld(&bar[XB_TOPGEN]) == tg, bar);
            __builtin_amdgcn_fence(__ATOMIC_ACQUIRE, "agent");
            xb_add(&bar[XB_XGEN(b.x)], 1u);
            asm volatile("s_waitcnt vmcnt(0)" ::: "memory");
        } else {
            XB_SPIN(xb_ld(&bar[XB_XGEN(b.x)]) == gen, bar);
            __builtin_amdgcn_fence(__ATOMIC_ACQUIRE, "agent");
            asm volatile("s_waitcnt vmcnt(0)" ::: "memory");
        }
    }
    __syncthreads();
}

__global__ void __launch_bounds__(512) fwd_megakernel(Params p) {
    __builtin_assume(__builtin_amdgcn_workitem_id_y() == 0);
    __builtin_assume(__builtin_amdgcn_workitem_id_z() == 0);
    extern __shared__ __attribute__((aligned(16))) unsigned char lds[];
    cg::grid_group grid = cg::this_grid();
    const int tid = threadIdx.x;
    bf16_t* ws16 = (bf16_t*)p.ws;
    volatile LAS unsigned* xst = (volatile LAS unsigned*)(LAS unsigned char*)(lds + LDS_BYTES - 32);
    if (tid == 0) { xst[0] = 0u; xst[1] = 0u; }
    __syncthreads();
    XcdBarrier xb; xb.bar = (unsigned*)(p.ws + WS_BAR); xb.x = 0; xb.st = xst;
    if (p.phase_hi - p.phase_lo > 1) xb = xcd_barrier_post((unsigned*)(p.ws + WS_BAR), xst);
    if ((ONLY_PHASE < 0 || ONLY_PHASE == 0) && p.phase_lo <= 0 && 0 < p.phase_hi)
    for (int rep_ = 0; rep_ < (PROBE_DUP == 0 ? 2 : 1); ++rep_) {
        if (rep_) xcd_barrier(xb);
        {
            if (blockIdx.x == 0 && tid < 8) ((unsigned*)(p.ws + WS_CNT))[tid] = 0u;
            for (int it = blockIdx.x; it < 288; it += gridDim.x) ada_item(p, (float*)lds, it);
            {
                float* rope = (float*)(p.ws + WS_ROPE);
                const int gi = blockIdx.x * 512 + tid;
                if (gi < 1024) {
                    const int pos = gi >> 4, fi = gi & 15;
                    const double invf = pow(10000.0, -(double)fi / 16.0);
                    const float ang = (float)pos * (float)invf;
                    rope[gi * 2] = (float)cos((double)ang); rope[gi * 2 + 1] = (float)sin((double)ang);
                }
            }
            int base = 288;
            conv_job((float*)lds, base, p.w_ffn1_in, 2048, 11008, (bf16_t*)(p.ws + WS_WT_FFN_IN), 11008, 1);
            conv_job((float*)lds, base, p.w_ffn1_out, 5504, 2048, (bf16_t*)(p.ws + WS_WT_FFN_OUT), 2048, 0);
            conv_job((float*)lds, base, p.w_in, 2048, 11360, (bf16_t*)(p.ws + WS_WT_IN), 11520, 0);
            conv_job((float*)lds, base, p.w_uq, 512, 3072, (bf16_t*)(p.ws + WS_WT_UQ), 3072, 0);
            conv_job((float*)lds, base, p.w_ukv, 512, 4096, (bf16_t*)(p.ws + WS_WT_UKV), 4096, 0);
        }
    }
    if (p.phase_lo <= 0 && 0 + 1 < p.phase_hi) xcd_barrier(xb);
    if (p.phase_lo == -12345) grid.sync();
    if ((ONLY_PHASE < 0 || ONLY_PHASE == 1) && p.phase_lo <= 1 && 1 < p.phase_hi)
    for (int rep_ = 0; rep_ < (PROBE_DUP == 1 ? 2 : 1); ++rep_) {
        if (rep_) xcd_barrier(xb);
        {
            const float* modp = (const float*)(p.ws + WS_MODP);
            float* mod = (float*)(p.ws + WS_MOD);
            for (int i = blockIdx.x * 512 + tid; i < 5 * 18432; i += gridDim.x * 512) {
                const int n = i % 18432;
                mod[i] = p.b_ada[n] + modp[i] + modp[i + 5 * 18432] + modp[i + 2 * 5 * 18432] + modp[i + 3 * 5 * 18432];
            }
        }
    }
    if (p.phase_lo <= 1 && 1 + 1 < p.phase_hi) xcd_barrier(xb);
    if ((ONLY_PHASE < 0 || ONLY_PHASE == 2) && p.phase_lo <= 2 && 2 < p.phase_hi)
    for (int rep_ = 0; rep_ < (PROBE_DUP == 2 ? 2 : 1); ++rep_) {
        if (rep_) xcd_barrier(xb);
        row_phase(p, 1);
    }
    if (p.phase_lo <= 2 && 2 + 1 < p.phase_hi) xcd_barrier(xb);
    if ((ONLY_PHASE < 0 || ONLY_PHASE == 3) && p.phase_lo <= 3 && 3 < p.phase_hi)
    for (int rep_ = 0; rep_ < (PROBE_DUP == 3 ? 2 : 1); ++rep_) {
        if (rep_) xcd_barrier(xb);
        { EpiSwiglu e{(bf16_t*)(p.ws + WS_R1)}; run_gemm(lds, (const bf16_t*)(p.ws + WS_H), (const bf16_t*)(p.ws + WS_WT_FFN_IN), TT, 11008, 2048, e); }
    }
    if (p.phase_lo <= 3 && 3 + 1 < p.phase_hi) xcd_barrier(xb);
    if ((ONLY_PHASE < 0 || ONLY_PHASE == 4) && p.phase_lo <= 4 && 4 < p.phase_hi)
    for (int rep_ = 0; rep_ < (PROBE_DUP == 4 ? 2 : 1); ++rep_) {
        if (rep_) xcd_barrier(xb);
        { EpiF32 e{(bf16_t*)(p.ws + WS_R2), DM, (bf16_t*)(p.ws + WS_Y1)}; run_gemm(lds, (const bf16_t*)(p.ws + WS_R1), (const bf16_t*)(p.ws + WS_WT_FFN_OUT), TT, 2048, DFF, e, 2); }
    }
    if (p.phase_lo <= 4 && 4 + 1 < p.phase_hi) xcd_barrier(xb);
    if ((ONLY_PHASE < 0 || ONLY_PHASE == 5) && p.phase_lo <= 5 && 5 < p.phase_hi)
    for (int rep_ = 0; rep_ < (PROBE_DUP == 5 ? 2 : 1); ++rep_) {
        if (rep_) xcd_barrier(xb);
        row_phase(p, 2);
    }
    if (p.phase_lo <= 5 && 5 + 1 < p.phase_hi) xcd_barrier(xb);
    if ((ONLY_PHASE < 0 || ONLY_PHASE == 6) && p.phase_lo <= 6 && 6 < p.phase_hi)
    for (int rep_ = 0; rep_ < (PROBE_DUP == 6 ? 2 : 1); ++rep_) {
        if (rep_) xcd_barrier(xb);
        { EpiProj e{(bf16_t*)(p.ws + WS_R1), (bf16_t*)(p.ws + WS_VGT), (float*)(p.ws + WS_SMALL)}; run_gemm(lds, (const bf16_t*)(p.ws + WS_H), (const bf16_t*)(p.ws + WS_WT_IN), TT, 11520, 2048, e); }
    }
    if (p.phase_lo <= 6 && 6 + 1 < p.phase_hi) xcd_barrier(xb);
    if ((ONLY_PHASE < 0 || ONLY_PHASE == 7) && p.phase_lo <= 7 && 7 < p.phase_hi)
    for (int rep_ = 0; rep_ < (PROBE_DUP == 7 ? 2 : 1); ++rep_) {
        if (rep_) xcd_barrier(xb);
        {
            token_phase(p);
        }
    }
    if (p.phase_lo <= 7 && 7 + 1 < p.phase_hi) xcd_barrier(xb);
    if ((ONLY_PHASE < 0 || ONLY_PHASE == 8) && p.phase_lo <= 8 && 8 < p.phase_hi)
    for (int rep_ = 0; rep_ < (PROBE_DUP == 8 ? 2 : 1); ++rep_) {
        if (rep_) xcd_barrier(xb);
        { EpiQ e{(bf16_t*)(p.ws + WS_Q), (const float*)(p.ws + WS_ROPE)}; run_gemm(lds, (const bf16_t*)(p.ws + WS_CQN), (const bf16_t*)(p.ws + WS_WT_UQ), TT, 3072, 512, e); }
    }
    if (p.phase_lo <= 8 && 8 + 1 < p.phase_hi) xcd_barrier(xb);
    if ((ONLY_PHASE < 0 || ONLY_PHASE == 9) && p.phase_lo <= 9 && 9 < p.phase_hi)
    for (int rep_ = 0; rep_ < (PROBE_DUP == 9 ? 2 : 1); ++rep_) {
        if (rep_) xcd_barrier(xb);
        { EpiKV e{(bf16_t*)(p.ws + WS_KN), (bf16_t*)(p.ws + WS_VT)}; run_gemm(lds, (const bf16_t*)(p.ws + WS_CKVA), (const bf16_t*)(p.ws + WS_WT_UKV), KVR, 4096, 512, e); }
    }
    if (p.phase_lo <= 9 && 9 + 1 < p.phase_hi) xcd_barrier(xb);
    if ((ONLY_PHASE < 0 || ONLY_PHASE == 10) && p.phase_lo <= 10 && 10 < p.phase_hi)
    for (int rep_ = 0; rep_ < (PROBE_DUP == 10 ? 2 : 1); ++rep_) {
        if (rep_) xcd_barrier(xb);
        attn_phase(p, lds, rep_ ? 5 : 1);
    }
    if (p.phase_lo <= 10 && 10 + 1 < p.phase_hi) xcd_barrier(xb);
    if ((ONLY_PHASE < 0 || ONLY_PHASE == 11) && p.phase_lo <= 11 && 11 < p.phase_hi)
    for (int rep_ = 0; rep_ < (PROBE_DUP == 11 ? 2 : 1); ++rep_) {
        if (rep_) xcd_barrier(xb);
        gla_a_phase(p, lds, rep_ ? 4 : 0);
    }
    if (p.phase_lo <= 11 && 11 + 1 < p.phase_hi) xcd_barrier(xb);
    if ((ONLY_PHASE < 0 || ONLY_PHASE == 12) && p.phase_lo <= 12 && 12 < p.phase_hi)
    for (int rep_ = 0; rep_ < (PROBE_DUP == 12 ? 2 : 1); ++rep_) {
        if (rep_) xcd_barrier(xb);
        gla_b_phase(p, lds, rep_ ? 6 : 2);
    }
    if (p.phase_lo <= 12 && 12 + 1 < p.phase_hi) xcd_barrier(xb);
    if ((ONLY_PHASE < 0 || ONLY_PHASE == 13) && p.phase_lo <= 13 && 13 < p.phase_hi)
    for (int rep_ = 0; rep_ < (PROBE_DUP == 13 ? 2 : 1); ++rep_) {
        if (rep_) xcd_barrier(xb);
        gla_post_phase(p);
    }
    if (p.phase_lo <= 13 && 13 + 1 < p.phase_hi) xcd_barrier(xb);
    if ((ONLY_PHASE < 0 || ONLY_PHASE == 14) && p.phase_lo <= 14 && 14 < p.phase_hi)
    for (int rep_ = 0; rep_ < (PROBE_DUP == 14 ? 2 : 1); ++rep_) {
        if (rep_) xcd_barrier(xb);
        { EpiGate e{(const bf16_t*)(p.ws + WS_R1), (bf16_t*)(p.ws + WS_H)}; run_gemm(lds, (const bf16_t*)(p.ws + WS_Q), (const bf16_t*)(p.ws + WS_WT_G), TT, 2048, 2048, e, 1, (const bf16_t*)(p.ws + WS_OM), (const bf16_t*)(p.ws + WS_WT_M)); }
        {
            const int G = gridDim.x, nfull = 384 - G > 0 ? 384 - G : 0;
            int wb = (int)blockIdx.x - nfull, nw = G - nfull;
            if (nw <= 0) { wb = blockIdx.x; nw = G; }
            if (wb >= 0) {
                int base = 0;
                conv_job((float*)lds, base, p.w_ffn2_in, 2048, 11008, (bf16_t*)(p.ws + WS_WT_FFN_IN), 11008, 1, wb, nw);
                conv_job((float*)lds, base, p.w_ffn2_out, 5504, 2048, (bf16_t*)(p.ws + WS_WT_FFN_OUT), 2048, 0, wb, nw);
            }
        }
    }
    if (p.phase_lo <= 14 && 14 + 1 < p.phase_hi) xcd_barrier(xb);
    if ((ONLY_PHASE < 0 || ONLY_PHASE == 15) && p.phase_lo <= 15 && 15 < p.phase_hi)
    for (int rep_ = 0; rep_ < (PROBE_DUP == 15 ? 2 : 1); ++rep_) {
        if (rep_) xcd_barrier(xb);
        { EpiF32 e{(bf16_t*)(p.ws + WS_R2), DM, (bf16_t*)(p.ws + WS_Y1)}; run_gemm(lds, (const bf16_t*)(p.ws + WS_H), (const bf16_t*)(p.ws + WS_WT_OUT), TT, 2048, 2048, e, 2); }
    }
    if (p.phase_lo <= 15 && 15 + 1 < p.phase_hi) xcd_barrier(xb);
    if ((ONLY_PHASE < 0 || ONLY_PHASE == 16) && p.phase_lo <= 16 && 16 < p.phase_hi)
    for (int rep_ = 0; rep_ < (PROBE_DUP == 16 ? 2 : 1); ++rep_) {
        if (rep_) xcd_barrier(xb);
        row_phase(p, 3);
    }
    if (p.phase_lo <= 16 && 16 + 1 < p.phase_hi) xcd_barrier(xb);
    if ((ONLY_PHASE < 0 || ONLY_PHASE == 17) && p.phase_lo <= 17 && 17 < p.phase_hi)
    for (int rep_ = 0; rep_ < (PROBE_DUP == 17 ? 2 : 1); ++rep_) {
        if (rep_) xcd_barrier(xb);
        { EpiSwiglu e{(bf16_t*)(p.ws + WS_R1)}; run_gemm(lds, (const bf16_t*)(p.ws + WS_H), (const bf16_t*)(p.ws + WS_WT_FFN_IN), TT, 11008, 2048, e); }
    }
    if (p.phase_lo <= 17 && 17 + 1 < p.phase_hi) xcd_barrier(xb);
    if ((ONLY_PHASE < 0 || ONLY_PHASE == 18) && p.phase_lo <= 18 && 18 < p.phase_hi)
    for (int rep_ = 0; rep_ < (PROBE_DUP == 18 ? 2 : 1); ++rep_) {
        if (rep_) xcd_barrier(xb);
        { EpiF32 e{(bf16_t*)(p.ws + WS_R2), DM, (bf16_t*)(p.ws + WS_Y1)}; run_gemm(lds, (const bf16_t*)(p.ws + WS_R1), (const bf16_t*)(p.ws + WS_WT_FFN_OUT), TT, 2048, DFF, e, 2); }
    }
    if (p.phase_lo <= 18 && 18 + 1 < p.phase_hi) xcd_barrier(xb);
    if ((ONLY_PHASE < 0 || ONLY_PHASE == 19) && p.phase_lo <= 19 && 19 < p.phase_hi)
    for (int rep_ = 0; rep_ < (PROBE_DUP == 19 ? 2 : 1); ++rep_) {
        if (rep_) xcd_barrier(xb);
        row_phase(p, 4);
    }
    (void)ws16;
}

extern "C" void kernel_launch(void* const* d_in, const int* in_sizes, int n_in, void* d_out, int out_size, void* d_ws, size_t ws_size, hipStream_t stream) {
    (void)in_sizes; (void)n_in; (void)out_size;
    static int grid_blocks = 0;
    if (!grid_blocks) {
        hipFuncSetAttribute((const void*)fwd_megakernel, hipFuncAttributeMaxDynamicSharedMemorySize, LDS_BYTES);
        int dev = 0, cus = 0, per_cu = 0;
        hipGetDevice(&dev);
        hipDeviceGetAttribute(&cus, hipDeviceAttributeMultiprocessorCount, dev);
        hipOccupancyMaxActiveBlocksPerMultiprocessor(&per_cu, fwd_megakernel, 512, LDS_BYTES);
        if (per_cu < 1) per_cu = 1;
        grid_blocks = cus * 1;
    }
    if (ws_size < WS_END) { fprintf(stderr, "workspace too small: %zu < %zu\n", ws_size, (size_t)WS_END); return; }
    Params p{};
    const float* const* in = (const float* const*)d_in;
    p.x_prompt = in[0]; p.x_sample = in[1]; p.cache_ckv = in[2]; p.cache_krope = in[3]; p.st_f = in[4]; p.st_b = in[5]; p.c = in[6]; p.c_ctx = in[7];
    p.w_ada = in[8]; p.b_ada = in[9]; p.norm_gains = in[10]; p.w_ffn1_in = in[11]; p.w_ffn1_out = in[12]; p.w_ffn2_in = in[13]; p.w_ffn2_out = in[14];
    p.w_in = in[15]; p.w_gla_alpha = in[16]; p.b_gla_alpha = in[17]; p.gla_norm = in[18]; p.w_gla_out = in[19]; p.q_norm = in[20]; p.kv_norm = in[21];
    p.w_uq = in[22]; p.w_ukv = in[23]; p.w_mla_out = in[24]; p.w_out = in[25];
    p.out = (float*)d_out; p.ws = (char*)d_ws;
#if N_LAUNCH_SPLIT
    for (int ph = 0; ph < NPHASE; ++ph) {
        p.phase_lo = ph; p.phase_hi = ph + 1;
        hipLaunchKernelGGL(fwd_megakernel, dim3(grid_blocks), dim3(512), LDS_BYTES, stream, p);
    }
#else
    p.phase_lo = 0; p.phase_hi = NPHASE;
    (void)hipMemsetAsync((char*)d_ws + WS_BAR, 0, XCD_BAR_WORDS * 4, stream);
    void* args[] = {&p};
    hipError_t e = hipLaunchCooperativeKernel((const void*)fwd_megakernel, dim3(grid_blocks), dim3(512), args, LDS_BYTES, stream);
    if (e != hipSuccess) fprintf(stderr, "cooperative launch failed: %s (grid %d)\n", hipGetErrorString(e), grid_blocks);
#endif
}
```

```cpp
#include <hip/hip_runtime.h>
#include <hip/hip_cooperative_groups.h>
#include <cstdio>
namespace cg = cooperative_groups;

typedef unsigned short bf16_t;
typedef short bf16x8 __attribute__((ext_vector_type(8)));
typedef short bf16x4 __attribute__((ext_vector_type(4)));
typedef float f32x4 __attribute__((ext_vector_type(4)));
typedef unsigned u32x2 __attribute__((ext_vector_type(2)));
typedef unsigned u32x4 __attribute__((ext_vector_type(4)));
#define LAS __attribute__((address_space(3)))

#ifndef ONLY_PHASE
#define ONLY_PHASE -1
#endif
#ifndef PROBE_DUP
#define PROBE_DUP -1
#endif
#ifndef N_LAUNCH_SPLIT
#define N_LAUNCH_SPLIT 0
#endif

constexpr int TT = 12288;
constexpr int NCTX = 4096;
constexpr int DM = 2048;
constexpr int DFF = 5504;
constexpr int KVR = 13312;
constexpr int PROJ_LD = 8192;
constexpr int SMALL_LD = 1120;
constexpr int NPHASE = 20;
constexpr int LDS_BYTES = 147456;

constexpr size_t OUT_Y = 0, OUT_CKV = 25165824, OUT_KROPE = 27262976, OUT_SF = 27525120, OUT_SB = 35913728;

constexpr size_t WS_WT_FFN_IN = 0;
constexpr size_t WS_WT_FFN_OUT = WS_WT_FFN_IN + (size_t)11008 * 2048 * 2;
constexpr size_t WS_WT_IN = WS_WT_FFN_OUT + (size_t)2048 * 5504 * 2;
constexpr size_t WS_WT_G = WS_WT_IN + (size_t)11520 * 2048 * 2;
constexpr size_t WS_WT_M = WS_WT_G + (size_t)2048 * 2048 * 2;
constexpr size_t WS_WT_UQ = WS_WT_M + (size_t)2048 * 2048 * 2;
constexpr size_t WS_WT_UKV = WS_WT_UQ + (size_t)3072 * 512 * 2;
constexpr size_t WS_WT_OUT = WS_WT_UKV + (size_t)4096 * 512 * 2;
constexpr size_t WS_MODP = WS_WT_OUT + (size_t)2048 * 2048 * 2;
constexpr size_t WS_MOD = WS_MODP + (size_t)4 * 5 * 18432 * 4;
constexpr size_t WS_ROPE = WS_MOD + (size_t)5 * 18432 * 4;
constexpr size_t WS_CNT = WS_ROPE + 8192;
constexpr size_t WS_BAR = WS_CNT + 256;
constexpr size_t WS_H = WS_BAR + 13824;
constexpr size_t WS_CQN = WS_H;
constexpr size_t WS_CKVA = WS_CQN + (size_t)TT * 512 * 2;
constexpr size_t WS_KRA = WS_CKVA + (size_t)KVR * 512 * 2;
constexpr size_t WS_ACMP = WS_KRA + (size_t)KVR * 64 * 2;
constexpr size_t WS_R1 = WS_H + (size_t)TT * 2048 * 2;
constexpr size_t WS_R2 = WS_R1 + (size_t)TT * PROJ_LD * 2;
constexpr size_t WS_SMALL = WS_R2 + (size_t)TT * 2048 * 4;
constexpr size_t WS_Q = WS_SMALL + (size_t)TT * SMALL_LD * 4;
constexpr size_t WS_VGT = WS_Q + (size_t)TT * 3072 * 2;
constexpr size_t WS_OM = WS_SMALL;
constexpr size_t WS_KN = 0;
constexpr size_t WS_VT = WS_KN + (size_t)KVR * 2048 * 2;
static_assert(WS_VT + (size_t)KVR * 2048 * 2 <= WS_WT_G, "KN/VT alias region");
constexpr size_t WS_Y1 = WS_R2 + (size_t)TT * 2048 * 2;
constexpr size_t WS_QD = 0;
constexpr size_t WS_KIT = WS_QD + (size_t)1536 * 64 * 256 * 2;
constexpr size_t WS_DEC = WS_KIT + (size_t)1536 * 64 * 256 * 2;
constexpr size_t WS_AM = WS_DEC + (size_t)1536 * 256 * 4;
static_assert(WS_AM + (size_t)1536 * 64 * 64 * 2 <= WS_WT_G, "GLA intermediates alias region");
static_assert(WS_ACMP + (size_t)TT * 32 * 4 <= WS_R1, "H alias region");
constexpr size_t WS_END = WS_VGT + (size_t)TT * 2048 * 2;

struct Params {
    const float *x_prompt, *x_sample, *cache_ckv, *cache_krope, *st_f, *st_b, *c, *c_ctx, *w_ada, *b_ada, *norm_gains,
        *w_ffn1_in, *w_ffn1_out, *w_ffn2_in, *w_ffn2_out, *w_in, *w_gla_alpha, *b_gla_alpha, *gla_norm, *w_gla_out,
        *q_norm, *kv_norm, *w_uq, *w_ukv, *w_mla_out, *w_out;
    float* out;
    char* ws;
    int phase_lo, phase_hi;
};

__device__ __forceinline__ unsigned cvt_pk_bf16(float lo, float hi) { unsigned r; asm volatile("v_cvt_pk_bf16_f32 %0, %1, %2" : "=v"(r) : "v"(lo), "v"(hi)); return r; }
__device__ __forceinline__ bf16_t f2bf(float f) { unsigned u = __float_as_uint(f); u += 0x7FFFu + ((u >> 16) & 1u); return (bf16_t)(u >> 16); }
__device__ __forceinline__ float bf2f(bf16_t h) { return __uint_as_float(((unsigned)h) << 16); }
__device__ __forceinline__ float bflo(unsigned u) { return __uint_as_float(u << 16); }
__device__ __forceinline__ float bfhi(unsigned u) { return __uint_as_float(u & 0xffff0000u); }
__device__ __forceinline__ float wave_sum(float v) {
#pragma unroll
    for (int o = 32; o > 0; o >>= 1) v += __shfl_xor(v, o);
    return v;
}
__device__ __forceinline__ float sigmoidf_(float x) { return __builtin_amdgcn_rcpf(1.f + __expf(-x)); }
__device__ __forceinline__ float siluf_(float x) { return x * __builtin_amdgcn_rcpf(1.f + __expf(-x)); }

namespace pg8 {
constexpr int BM = 256, BK = 64, HALF = 128, HTB = HALF * BK * 2, NXCD = 8, WGM = 8;
__device__ __forceinline__ int lds_byte(int r, int c) { const int st = (r >> 4) * 2 + (c >> 5), rr = r & 15, cc = c & 31, ob = rr * 64 + cc * 2; return st * 1024 + (ob ^ (((ob >> 9) & 1) << 5)); }
__device__ __forceinline__ void stage_rc(int b, int& R, int& C) { const int st = b / 1024, sb = b % 1024, swz = sb ^ (((sb >> 9) & 1) << 5); R = (st >> 1) * 16 + swz / 64; C = (st & 1) * 32 + (swz % 64) / 2; }
struct Unit { int pm, pn, ks, koff, nt, seg; };
struct Gemm { const bf16_t* A; const bf16_t* Bt; int M, N, K; const bf16_t* A1; const bf16_t* Bt1; };
struct StaticOrder {
    int nM, nN, nwg, G, c, nt0, nt1, nsplit, nseg;
    __device__ void init(int M, int N, int K, int G_, int c_, int split, int nseg_ = 1) {
        nM = M / BM; nN = N / BM; nwg = nM * nN; G = G_; c = c_; nsplit = split; nseg = nseg_;
        const int ntk = K / BK;
        if (split == 2) { nt0 = ((ntk / 2) + 1) & ~1; nt1 = ntk - nt0; } else { nt0 = ntk; nt1 = 0; }
    }
    __device__ bool next(int i, Unit& u) const {
        u.seg = 0; if (nseg == 2) { u.seg = i & 1; i >>= 1; }
        long L = (long)i * G + c; if (L >= (long)nwg * nsplit) return false;
        u.ks = L >= nwg ? 1 : 0; if (u.ks) L -= nwg;
        u.koff = u.ks ? nt0 * BK : 0; u.nt = u.ks ? nt1 : nt0;
        int wgid = (int)L; { const int q = nwg / NXCD, r = nwg % NXCD, xcd = wgid % NXCD, off = wgid / NXCD; wgid = (xcd < r ? xcd * (q + 1) : r * (q + 1) + (xcd - r) * q) + off; }
        const int nig = WGM * nN, gid = wgid / nig, fm = gid * WGM, gsz = (nM - fm) < WGM ? (nM - fm) : WGM;
        u.pm = fm + ((wgid % nig) % gsz); u.pn = (wgid % nig) / gsz; return true;
    }
};
template <class Epi>
__device__ __forceinline__ void gemm_phase(LAS unsigned char* lds, const Gemm g, const StaticOrder& S, const Epi& E) {
    const int tid = threadIdx.x, wid = __builtin_amdgcn_readfirstlane(tid >> 6), lane = tid & 63, wr = wid >> 2, wc = wid & 3, fr = lane & 15, fq = lane >> 4;
    const int K = g.K;
    unsigned voffA[2];
#pragma unroll
    for (int i = 0; i < 2; ++i) { int R, C; stage_rc(tid * 16 + i * 8192, R, C); voffA[i] = (unsigned)(R * K + C) * 2u; }
    const size_t kstep = (size_t)(BK * 2);
    const size_t hstep = (size_t)HALF * K * 2;
    const size_t tstep = 2 * hstep;
    const unsigned ldsw = (unsigned)wid * 1024u;
    const int aoff = lds_byte(wr * 64 + fr, fq * 8), boff = lds_byte(wc * 32 + fr, fq * 8);
#define PG8_SA(b, h) (((b) * 2 + (h)) * HTB)
#define PG8_SB(b, h) ((4 + (b) * 2 + (h)) * HTB)
#define PG8_STAGE(bufoff, gbase, voff) do { _Pragma("unroll") for (int _i = 0; _i < 2; ++_i) \
        __builtin_amdgcn_global_load_lds((const unsigned*)((const char*)(gbase) + (voff)[_i]), (LAS unsigned*)(lds + (bufoff) + ldsw + _i * 8192), 16, 0, 0); } while (0)
#define PG8_LDA(dst, b, h) do { _Pragma("unroll") for (int m = 0; m < 4; ++m) _Pragma("unroll") for (int k = 0; k < 2; ++k) dst[m][k] = *(const LAS bf16x8*)(lds + PG8_SA(b, h) + aoff + m * 2048 + k * 1024); } while (0)
#define PG8_LDB(dst, b, h) do { _Pragma("unroll") for (int n = 0; n < 2; ++n) _Pragma("unroll") for (int k = 0; k < 2; ++k) dst[n][k] = *(const LAS bf16x8*)(lds + PG8_SB(b, h) + boff + n * 2048 + k * 1024); } while (0)
#define PG8_MMA(ai, bj, At, Bt) do { __builtin_amdgcn_s_setprio(1); _Pragma("unroll") for (int m = 0; m < 4; ++m) _Pragma("unroll") for (int n = 0; n < 2; ++n) _Pragma("unroll") for (int k = 0; k < 2; ++k) \
        acc[ai][bj][m][n] = __builtin_amdgcn_mfma_f32_16x16x32_bf16(Bt[n][k], At[m][k], acc[ai][bj][m][n], 0, 0, 0); __builtin_amdgcn_s_setprio(0); } while (0)
#define PG8_WAIT_V(n) asm volatile("s_waitcnt vmcnt(" #n ")" ::: "memory")
#define PG8_WAIT_L(n) asm volatile("s_waitcnt lgkmcnt(" #n ")" ::: "memory")
#define PG8_BAR __builtin_amdgcn_s_barrier()
#define PG8_SCHED __builtin_amdgcn_sched_barrier(0)
    Unit cur, nxt; int ui = 0;
    if (!S.next(0, cur)) return;
    f32x4 acc[2][2][4][2];
#pragma unroll
    for (int a = 0; a < 2; ++a)
#pragma unroll
        for (int b = 0; b < 2; ++b)
#pragma unroll
            for (int m = 0; m < 4; ++m)
#pragma unroll
                for (int n = 0; n < 2; ++n) acc[a][b][m][n] = (f32x4){0.f, 0.f, 0.f, 0.f};
    bf16x8 At[4][2], B0[2][2], B1[2][2];
    const char* cA = (const char*)(cur.seg ? g.A1 : g.A) + (size_t)cur.pm * tstep + (size_t)cur.koff * 2; const char* cB = (const char*)(cur.seg ? g.Bt1 : g.Bt) + (size_t)cur.pn * tstep + (size_t)cur.koff * 2;
    PG8_STAGE(PG8_SB(0, 0), cB, voffA); PG8_STAGE(PG8_SA(0, 0), cA, voffA); PG8_STAGE(PG8_SB(0, 1), cB + hstep, voffA); PG8_STAGE(PG8_SA(0, 1), cA + hstep, voffA);
    if (wr == 1) PG8_BAR;
    PG8_WAIT_V(4); PG8_BAR;
    PG8_STAGE(PG8_SB(1, 0), cB + kstep, voffA); PG8_STAGE(PG8_SA(1, 0), cA + kstep, voffA); PG8_STAGE(PG8_SB(1, 1), cB + hstep + kstep, voffA);
    PG8_WAIT_V(6); PG8_BAR;
    for (;;) {
        const bool has_next = S.next(ui + 1, nxt);
        const char* nA = has_next ? (const char*)(nxt.seg ? g.A1 : g.A) + (size_t)nxt.pm * tstep + (size_t)nxt.koff * 2 : cA; const char* nB = has_next ? (const char*)(nxt.seg ? g.Bt1 : g.Bt) + (size_t)nxt.pn * tstep + (size_t)nxt.koff * 2 : cB;
        const int nt = cur.nt;
        for (int t = 0; t < nt; t += 2) {
            const bool last = (t == nt - 2);
            const char* a1 = cA + (size_t)(t + 1) * kstep;
            const char* a2 = last ? nA : cA + (size_t)(t + 2) * kstep; const char* b2 = last ? nB : cB + (size_t)(t + 2) * kstep;
            const char* a3 = a2 + kstep; const char* b3 = b2 + kstep;
            PG8_LDB(B0, 0, 0); PG8_SCHED; PG8_LDA(At, 0, 0); PG8_STAGE(PG8_SA(1, 1), a1 + hstep, voffA);
            PG8_WAIT_L(8); PG8_BAR; PG8_WAIT_L(0); PG8_MMA(0, 0, At, B0); PG8_BAR; PG8_SCHED;
            PG8_LDB(B1, 0, 1); PG8_STAGE(PG8_SB(0, 0), b2, voffA);
            PG8_BAR; PG8_WAIT_L(0); PG8_MMA(0, 1, At, B1); PG8_BAR;
            PG8_LDA(At, 0, 1); PG8_STAGE(PG8_SA(0, 0), a2, voffA);
            PG8_BAR; PG8_WAIT_L(0); PG8_MMA(1, 0, At, B0); PG8_BAR; PG8_SCHED;
            PG8_STAGE(PG8_SB(0, 1), b2 + hstep, voffA);
            PG8_WAIT_V(6); PG8_BAR; PG8_MMA(1, 1, At, B1); PG8_BAR;
            PG8_LDB(B0, 1, 0); PG8_SCHED; PG8_LDA(At, 1, 0); PG8_STAGE(PG8_SA(0, 1), a2 + hstep, voffA);
            PG8_WAIT_L(8); PG8_BAR; PG8_WAIT_L(0); PG8_MMA(0, 0, At, B0); PG8_BAR; PG8_SCHED;
            PG8_LDB(B1, 1, 1); PG8_STAGE(PG8_SB(1, 0), b3, voffA);
            PG8_BAR; PG8_WAIT_L(0); PG8_MMA(0, 1, At, B1); PG8_BAR;
            PG8_LDA(At, 1, 1); PG8_STAGE(PG8_SA(1, 0), a3, voffA);
            PG8_BAR; PG8_WAIT_L(0); PG8_MMA(1, 0, At, B0); PG8_BAR; PG8_SCHED;
            PG8_STAGE(PG8_SB(1, 1), b3 + hstep, voffA);
            PG8_WAIT_V(6); PG8_BAR; PG8_MMA(1, 1, At, B1); PG8_BAR;
        }
        bool keep = false;
        if constexpr (Epi::TWO_SEG) { if (cur.seg == 0) { E.mid(acc, cur, wr, wc, fr, fq); keep = true; } else E(acc, cur, wr, wc, fr, fq); }
        else E(acc, cur, wr, wc, fr, fq);
        if (!has_next) break;
        if (!keep)
#pragma unroll
        for (int a = 0; a < 2; ++a)
#pragma unroll
            for (int b = 0; b < 2; ++b)
#pragma unroll
                for (int m = 0; m < 4; ++m)
#pragma unroll
                    for (int n = 0; n < 2; ++n) acc[a][b][m][n] = (f32x4){0.f, 0.f, 0.f, 0.f};
        cur = nxt; cA = nA; cB = nB; ++ui;
    }
    PG8_WAIT_V(0);
    if (wr == 0) PG8_BAR;
    PG8_BAR;
#undef PG8_SA
#undef PG8_SB
#undef PG8_STAGE
#undef PG8_LDA
#undef PG8_LDB
#undef PG8_MMA
#undef PG8_WAIT_V
#undef PG8_WAIT_L
#undef PG8_BAR
#undef PG8_SCHED
}
}
using pg8::Unit;
typedef f32x4 AccT[2][2][4][2];

#define EPI_LOOP_BEGIN \
    _Pragma("unroll") for (int ai = 0; ai < 2; ++ai) _Pragma("unroll") for (int m = 0; m < 4; ++m) { const int row = u.pm * 256 + ai * 128 + wr * 64 + m * 16 + fr; \
    _Pragma("unroll") for (int bj = 0; bj < 2; ++bj) { const int cb = u.pn * 256 + bj * 128 + wc * 32; const f32x4 v0 = acc[ai][bj][m][0], v1 = acc[ai][bj][m][1];
#define EPI_LOOP_END } }

struct EpiF32 {
    static constexpr bool TWO_SEG = false;
    bf16_t* C; int ldc; bf16_t* C1;
    __device__ __forceinline__ void operator()(const AccT& acc, const Unit& u, int wr, int wc, int fr, int fq) const {
        bf16_t* Cb = u.ks ? C1 : C;
        EPI_LOOP_BEGIN
            bf16_t* p = Cb + (size_t)row * ldc + cb + 4 * fq;
            uint2 o0, o1; o0.x = cvt_pk_bf16(v0[0], v0[1]); o0.y = cvt_pk_bf16(v0[2], v0[3]); o1.x = cvt_pk_bf16(v1[0], v1[1]); o1.y = cvt_pk_bf16(v1[2], v1[3]);
            *(uint2*)p = o0; *(uint2*)(p + 16) = o1;
        EPI_LOOP_END
    }
};
struct EpiSwiglu {
    static constexpr bool TWO_SEG = false;
    bf16_t* O;
    __device__ __forceinline__ void operator()(const AccT& acc, const Unit& u, int wr, int wc, int fr, int fq) const {
        EPI_LOOP_BEGIN
            float r[4];
#pragma unroll
            for (int j = 0; j < 4; ++j) r[j] = siluf_(v0[j]) * v1[j];
            uint2 o; o.x = cvt_pk_bf16(r[0], r[1]); o.y = cvt_pk_bf16(r[2], r[3]);
            *(uint2*)(O + (size_t)row * DFF + (cb >> 1) + 4 * fq) = o;
        EPI_LOOP_END
    }
};
struct EpiProj {
    static constexpr bool TWO_SEG = false;
    bf16_t* proj; bf16_t* vgt; float* small;
    __device__ __forceinline__ void operator()(const AccT& acc, const Unit& u, int wr, int wc, int fr, int fq) const {
        EPI_LOOP_BEGIN
            if (cb >= 2048 && cb < 4096) {
#pragma unroll
                for (int j = 0; j < 4; ++j) {
                    vgt[(size_t)(cb - 2048 + 4 * fq + j) * TT + row] = f2bf(v0[j]);
                    vgt[(size_t)(cb - 2048 + 16 + 4 * fq + j) * TT + row] = f2bf(v1[j]);
                }
            } else if (cb >= 6144 && cb < 7264) {
                float* p = small + (size_t)row * SMALL_LD + (cb - 6144) + 4 * fq; *(f32x4*)p = v0; *(f32x4*)(p + 16) = v1;
            } else if (cb < 11360) {
                const int cc = cb < 2048 ? cb : (cb < 6144 ? cb - 2048 : cb - 7264 + 4096);
                bf16_t* p = proj + (size_t)row * PROJ_LD + cc + 4 * fq;
                uint2 o0, o1; o0.x = cvt_pk_bf16(v0[0], v0[1]); o0.y = cvt_pk_bf16(v0[2], v0[3]); o1.x = cvt_pk_bf16(v1[0], v1[1]); o1.y = cvt_pk_bf16(v1[2], v1[3]);
                *(uint2*)p = o0; *(uint2*)(p + 16) = o1;
            }
        EPI_LOOP_END
    }
};
struct EpiQ {
    static constexpr bool TWO_SEG = false;
    bf16_t* Q; const float* rope;
    __device__ __forceinline__ void operator()(const AccT& acc, const Unit& u, int wr, int wc, int fr, int fq) const {
        EPI_LOOP_BEGIN
            f32x4 a = v0, b = v1;
            const int w0 = cb % 192;
            if (w0 >= 128 && row >= NCTX) {
                const int it = (row - NCTX) & 2047;
                const int pos = (w0 == 128) ? (it >> 6) : (it & 63);
                const float* rp = rope + (pos * 16 + 4 * fq) * 2;
#pragma unroll
                for (int j = 0; j < 4; ++j) { const float cs = rp[2 * j], sn = rp[2 * j + 1]; a[j] = v0[j] * cs - v1[j] * sn; b[j] = v1[j] * cs + v0[j] * sn; }
            }
            bf16_t* p = Q + (size_t)row * 3072 + cb + 4 * fq;
            uint2 o0, o1; o0.x = cvt_pk_bf16(a[0], a[1]); o0.y = cvt_pk_bf16(a[2], a[3]); o1.x = cvt_pk_bf16(b[0], b[1]); o1.y = cvt_pk_bf16(b[2], b[3]);
            *(uint2*)p = o0; *(uint2*)(p + 16) = o1;
        EPI_LOOP_END
    }
};
struct EpiKV {
    static constexpr bool TWO_SEG = false;
    bf16_t* KN; bf16_t* VT;
    __device__ __forceinline__ void operator()(const AccT& acc, const Unit& u, int wr, int wc, int fr, int fq) const {
        EPI_LOOP_BEGIN
            const int head = cb >> 8, w0 = cb & 255;
            if (w0 < 128) {
                bf16_t* p = KN + (size_t)row * 2048 + head * 128 + w0 + 4 * fq;
                uint2 o0, o1; o0.x = cvt_pk_bf16(v0[0], v0[1]); o0.y = cvt_pk_bf16(v0[2], v0[3]); o1.x = cvt_pk_bf16(v1[0], v1[1]); o1.y = cvt_pk_bf16(v1[2], v1[3]);
                *(uint2*)p = o0; *(uint2*)(p + 16) = o1;
            } else {
                const int dv = head * 128 + (w0 - 128) + 4 * fq;
#pragma unroll
                for (int j = 0; j < 4; ++j) { VT[(size_t)(dv + j) * KVR + row] = f2bf(v0[j]); VT[(size_t)(dv + 16 + j) * KVR + row] = f2bf(v1[j]); }
            }
        EPI_LOOP_END
    }
};
struct EpiGate {
    static constexpr bool TWO_SEG = true;
    const bf16_t* proj; bf16_t* Mo;
    __device__ __forceinline__ void mid(AccT& acc, const Unit& u, int wr, int wc, int fr, int fq) const {
#pragma unroll
        for (int ai = 0; ai < 2; ++ai) {
            uint2 ga[4][2][2], gb[4][2][2];
#pragma unroll
            for (int m = 0; m < 4; ++m)
#pragma unroll
                for (int bj = 0; bj < 2; ++bj) {
                    const int row = u.pm * 256 + ai * 128 + wr * 64 + m * 16 + fr, cb = u.pn * 256 + bj * 128 + wc * 32;
                    const bf16_t* gp = proj + (size_t)row * PROJ_LD + 4096 + cb + 4 * fq;
                    ga[m][bj][0] = *(const uint2*)gp; ga[m][bj][1] = *(const uint2*)(gp + 16); gb[m][bj][0] = *(const uint2*)(gp + 2048); gb[m][bj][1] = *(const uint2*)(gp + 2048 + 16);
                }
#pragma unroll
            for (int m = 0; m < 4; ++m)
#pragma unroll
                for (int bj = 0; bj < 2; ++bj)
#pragma unroll
                    for (int n = 0; n < 2; ++n) {
                        const uint2 a = ga[m][bj][n], bb = gb[m][bj][n];
                        f32x4 r;
                        r[0] = (1.f + __expf(-bflo(bb.x))) * __builtin_amdgcn_rcpf(1.f + __expf(-bflo(a.x))); r[1] = (1.f + __expf(-bfhi(bb.x))) * __builtin_amdgcn_rcpf(1.f + __expf(-bfhi(a.x)));
                        r[2] = (1.f + __expf(-bflo(bb.y))) * __builtin_amdgcn_rcpf(1.f + __expf(-bflo(a.y))); r[3] = (1.f + __expf(-bfhi(bb.y))) * __builtin_amdgcn_rcpf(1.f + __expf(-bfhi(a.y)));
                        acc[ai][bj][m][n] *= r;
                    }
        }
    }
    __device__ __forceinline__ void operator()(const AccT& acc, const Unit& u, int wr, int wc, int fr, int fq) const {
#pragma unroll
        for (int ai = 0; ai < 2; ++ai) {
            uint2 gb[4][2][2];
#pragma unroll
            for (int m = 0; m < 4; ++m)
#pragma unroll
                for (int bj = 0; bj < 2; ++bj) {
                    const int row = u.pm * 256 + ai * 128 + wr * 64 + m * 16 + fr, cb = u.pn * 256 + bj * 128 + wc * 32;
                    const bf16_t* gp = proj + (size_t)row * PROJ_LD + 6144 + cb + 4 * fq;
                    gb[m][bj][0] = *(const uint2*)gp; gb[m][bj][1] = *(const uint2*)(gp + 16);
                }
#pragma unroll
            for (int m = 0; m < 4; ++m)
#pragma unroll
                for (int bj = 0; bj < 2; ++bj) {
                    const int row = u.pm * 256 + ai * 128 + wr * 64 + m * 16 + fr, cb = u.pn * 256 + bj * 128 + wc * 32;
                    const f32x4 v0 = acc[ai][bj][m][0], v1 = acc[ai][bj][m][1];
                    const uint2 g0 = gb[m][bj][0], g1 = gb[m][bj][1];
                    f32x4 a, b;
                    a[0] = v0[0] * sigmoidf_(bflo(g0.x)); a[1] = v0[1] * sigmoidf_(bfhi(g0.x)); a[2] = v0[2] * sigmoidf_(bflo(g0.y)); a[3] = v0[3] * sigmoidf_(bfhi(g0.y));
                    b[0] = v1[0] * sigmoidf_(bflo(g1.x)); b[1] = v1[1] * sigmoidf_(bfhi(g1.x)); b[2] = v1[2] * sigmoidf_(bflo(g1.y)); b[3] = v1[3] * sigmoidf_(bfhi(g1.y));
                    bf16_t* p = Mo + (size_t)row * DM + cb + 4 * fq;
                    uint2 o0, o1; o0.x = cvt_pk_bf16(a[0], a[1]); o0.y = cvt_pk_bf16(a[2], a[3]); o1.x = cvt_pk_bf16(b[0], b[1]); o1.y = cvt_pk_bf16(b[2], b[3]);
                    *(uint2*)p = o0; *(uint2*)(p + 16) = o1;
                }
        }
    }
};

template <class Epi>
__device__ __forceinline__ void run_gemm(unsigned char* lds, const bf16_t* A, const bf16_t* Bt, int M, int N, int K, const Epi& E, int split = 1, const bf16_t* A1 = nullptr, const bf16_t* Bt1 = nullptr) {
    pg8::Gemm g{A, Bt, M, N, K, A1 ? A1 : A, Bt1 ? Bt1 : Bt};
    pg8::StaticOrder S; S.init(M, N, K, gridDim.x, blockIdx.x, split, A1 ? 2 : 1);
    pg8::gemm_phase<Epi>((LAS unsigned char*)lds, g, S, E);
    __syncthreads();
}

constexpr int CNT = 4;
__device__ __forceinline__ void conv_tile(float* tl, const float* __restrict__ src, int K, int N, bf16_t* dst, int mode, int nt, int kt) {
    const int tid = threadIdx.x;
    const int nl = tid & 63, k8 = tid >> 6;
    float v[CNT][8];
#pragma unroll
    for (int s2 = 0; s2 < CNT; ++s2) {
        const int np = (nt * CNT + s2) * 64 + nl;
        int j = np;
        if (mode == 1) { const int blk = np >> 5, r = np & 31; j = blk * 16 + (r & 15) + ((r >> 4) ? DFF : 0); }
        const bool valid = j < N;
#pragma unroll
        for (int i = 0; i < 8; ++i) {
            const int k = kt * 64 + k8 + 8 * i;
            v[s2][i] = valid ? __builtin_nontemporal_load(&src[(size_t)k * N + j]) : 0.f;
        }
    }
#pragma unroll
    for (int s2 = 0; s2 < CNT; ++s2)
#pragma unroll
        for (int i = 0; i < 8; ++i) tl[s2 * 64 * 65 + (k8 + 8 * i) * 65 + nl] = v[s2][i];
    __syncthreads();
    const int n2 = tid >> 3, kc = (tid & 7) * 8;
#pragma unroll
    for (int s2 = 0; s2 < CNT; ++s2) {
        const float* t2 = tl + s2 * 64 * 65;
        uint4 o;
        o.x = cvt_pk_bf16(t2[(kc + 0) * 65 + n2], t2[(kc + 1) * 65 + n2]);
        o.y = cvt_pk_bf16(t2[(kc + 2) * 65 + n2], t2[(kc + 3) * 65 + n2]);
        o.z = cvt_pk_bf16(t2[(kc + 4) * 65 + n2], t2[(kc + 5) * 65 + n2]);
        o.w = cvt_pk_bf16(t2[(kc + 6) * 65 + n2], t2[(kc + 7) * 65 + n2]);
        *(uint4*)(dst + (size_t)((nt * CNT + s2) * 64 + n2) * K + kt * 64 + kc) = o;
    }
    __syncthreads();
}
__device__ __forceinline__ void conv_job(float* tl, int& base, const float* src, int K, int N, bf16_t* dst, int nrows, int mode, int bidx = -1, int nblk = 0) {
    if (bidx < 0) { bidx = blockIdx.x; nblk = gridDim.x; }
    const int kts = K / 64, ntile = (nrows / (64 * CNT)) * kts;
    int first = bidx - (base % nblk); if (first < 0) first += nblk;
    for (int t = first; t < ntile; t += nblk) conv_tile(tl, src, K, N, dst, mode, t / kts, t % kts);
    base += ntile;
}

__device__ __forceinline__ void ada_item(const Params& p, float* lds, int item) {
    const int tid = threadIdx.x, w = tid >> 6, lane = tid & 63;
    const int nc = item % 72, ks = item / 72;
    float* sc = lds;
    float* red = lds + 5 * 512;
    for (int i = tid; i < 5 * 512; i += 512) {
        const int r = i / 512, k = ks * 512 + (i % 512);
        const float v = r == 0 ? p.c_ctx[k] : p.c[(r - 1) * DM + k];
        sc[i] = siluf_(v);
    }
    __syncthreads();
    float acc[5][4];
#pragma unroll
    for (int r = 0; r < 5; ++r)
#pragma unroll
        for (int j = 0; j < 4; ++j) acc[r][j] = 0.f;
    const float* wp = p.w_ada + (size_t)(ks * 512 + w * 64) * 18432 + nc * 256 + lane * 4;
#pragma unroll 8
    for (int kk = 0; kk < 64; ++kk) {
        const f32x4 wv = __builtin_nontemporal_load((const f32x4*)(wp + (size_t)kk * 18432));
#pragma unroll
        for (int r = 0; r < 5; ++r) {
            const float s = sc[r * 512 + w * 64 + kk];
#pragma unroll
            for (int j = 0; j < 4; ++j) acc[r][j] += s * wv[j];
        }
    }
#pragma unroll
    for (int r = 0; r < 5; ++r) *(f32x4*)(red + (w * 5 + r) * 256 + lane * 4) = (f32x4){acc[r][0], acc[r][1], acc[r][2], acc[r][3]};
    __syncthreads();
    float* modp = (float*)(p.ws + WS_MODP);
    for (int i = tid; i < 5 * 256; i += 512) {
        const int r = i / 256, cidx = i % 256;
        float s = 0.f;
#pragma unroll
        for (int ww = 0; ww < 8; ++ww) s += red[(ww * 5 + r) * 256 + cidx];
        modp[(size_t)(ks * 5 + r) * 18432 + nc * 256 + cidx] = s;
    }
    __syncthreads();
}

__device__ __forceinline__ void row_phase(const Params& p, int mode) {
    const int w = threadIdx.x >> 6, lane = threadIdx.x & 63;
    const float* mod = (const float*)(p.ws + WS_MOD);
    float* XR = p.out + OUT_Y;
    const bf16_t* Y = (const bf16_t*)(p.ws + WS_R2);
    const bf16_t* Y1 = (const bf16_t*)(p.ws + WS_Y1);
    bf16_t* H = (bf16_t*)(p.ws + WS_H);
    for (int row = blockIdx.x * 8 + w; row < TT; row += gridDim.x * 8) {
        const int mr = row < NCTX ? 0 : 1 + ((row - NCTX) >> 11);
        const float* mrow = mod + (size_t)mr * 18432;
        const float* xin = (mode <= 2) ? (row < NCTX ? p.x_prompt + (size_t)row * DM : p.x_sample + (size_t)(row - NCTX) * DM) : XR + (size_t)row * DM;
        f32x4 xv[8];
#pragma unroll
        for (int i = 0; i < 8; ++i) xv[i] = __builtin_nontemporal_load((const f32x4*)(xin + lane * 4 + 256 * i));
        if (mode >= 2) {
            const int gi = mode == 2 ? 2 : (mode == 3 ? 5 : 8), ni = mode == 2 ? 1 : (mode == 3 ? 3 : 5);
            const float coef = mode == 3 ? 1.f : 0.5f;
            f32x4 yv[8]; float ss = 0.f;
#pragma unroll
            for (int i = 0; i < 8; ++i) { const u32x2 ya = __builtin_nontemporal_load((const u32x2*)(Y + (size_t)row * DM + lane * 4 + 256 * i)), yb = __builtin_nontemporal_load((const u32x2*)(Y1 + (size_t)row * DM + lane * 4 + 256 * i));
                yv[i] = (f32x4){bflo(ya.x) + bflo(yb.x), bfhi(ya.x) + bfhi(yb.x), bflo(ya.y) + bflo(yb.y), bfhi(ya.y) + bfhi(yb.y)}; ss += yv[i][0] * yv[i][0] + yv[i][1] * yv[i][1] + yv[i][2] * yv[i][2] + yv[i][3] * yv[i][3]; }
            ss = wave_sum(ss);
            const float r = rsqrtf(ss * (1.f / DM) + 1e-6f);
#pragma unroll
            for (int i = 0; i < 8; ++i) {
                const f32x4 gt = *(const f32x4*)(mrow + gi * DM + lane * 4 + 256 * i);
                const f32x4 gn = *(const f32x4*)(p.norm_gains + ni * DM + lane * 4 + 256 * i);
#pragma unroll
                for (int j = 0; j < 4; ++j) xv[i][j] += coef * gt[j] * (yv[i][j] * r * gn[j]);
                if (mode == 4) __builtin_nontemporal_store(xv[i], (f32x4*)(XR + (size_t)row * DM + lane * 4 + 256 * i)); else *(f32x4*)(XR + (size_t)row * DM + lane * 4 + 256 * i) = xv[i];
            }
        }
        if (mode <= 3) {
            const int ni = mode == 1 ? 0 : (mode == 2 ? 2 : 4), shi = mode == 1 ? 0 : (mode == 2 ? 3 : 6);
            float ss = 0.f;
#pragma unroll
            for (int i = 0; i < 8; ++i) ss += xv[i][0] * xv[i][0] + xv[i][1] * xv[i][1] + xv[i][2] * xv[i][2] + xv[i][3] * xv[i][3];
            ss = wave_sum(ss);
            const float r = rsqrtf(ss * (1.f / DM) + 1e-6f);
#pragma unroll
            for (int i = 0; i < 8; ++i) {
                const f32x4 sh = *(const f32x4*)(mrow + shi * DM + lane * 4 + 256 * i);
                const f32x4 sc = *(const f32x4*)(mrow + (shi + 1) * DM + lane * 4 + 256 * i);
                const f32x4 gn = *(const f32x4*)(p.norm_gains + ni * DM + lane * 4 + 256 * i);
                float h[4];
#pragma unroll
                for (int j = 0; j < 4; ++j) h[j] = xv[i][j] * r * gn[j] * (1.f + sc[j]) + sh[j];
                uint2 o; o.x = cvt_pk_bf16(h[0], h[1]); o.y = cvt_pk_bf16(h[2], h[3]);
                *(uint2*)(H + (size_t)row * DM + lane * 4 + 256 * i) = o;
            }
        }
    }
}

__device__ __forceinline__ void token_phase(const Params& p) {
    const int w = threadIdx.x >> 6, lane = threadIdx.x & 63;
    const float* small = (const float*)(p.ws + WS_SMALL);
    const float* rope = (const float*)(p.ws + WS_ROPE);
    bf16_t* CQN = (bf16_t*)(p.ws + WS_CQN);
    bf16_t* CKVA = (bf16_t*)(p.ws + WS_CKVA);
    bf16_t* KRA = (bf16_t*)(p.ws + WS_KRA);
    for (int kr = blockIdx.x * 8 + w; kr < KVR; kr += gridDim.x * 8) {
        int tok = -1, bidx = 0, pp = 0;
        if (kr < NCTX) tok = kr;
        else { bidx = (kr - NCTX) / 2304; pp = (kr - NCTX) % 2304; if (pp >= 256) tok = NCTX + bidx * 2048 + (pp - 256); }
        if (tok < 0) {
            const float* s = p.cache_ckv + ((size_t)bidx * 256 + pp) * 512 + lane * 8;
            const f32x4 a = *(const f32x4*)s, b = *(const f32x4*)(s + 4);
            uint4 o; o.x = cvt_pk_bf16(a[0], a[1]); o.y = cvt_pk_bf16(a[2], a[3]); o.z = cvt_pk_bf16(b[0], b[1]); o.w = cvt_pk_bf16(b[2], b[3]);
            *(uint4*)(CKVA + (size_t)kr * 512 + lane * 8) = o;
            KRA[(size_t)kr * 64 + lane] = f2bf(p.cache_krope[((size_t)bidx * 256 + pp) * 64 + lane]);
            continue;
        }
        const float* srow = small + (size_t)tok * SMALL_LD;
        if (lane < 32) ((float*)(p.ws + WS_ACMP))[(size_t)tok * 32 + lane] = srow[lane];
        {
            const f32x4 a = __builtin_nontemporal_load((const f32x4*)(srow + 32 + lane * 8)), b = __builtin_nontemporal_load((const f32x4*)(srow + 36 + lane * 8));
            float ss = a[0] * a[0] + a[1] * a[1] + a[2] * a[2] + a[3] * a[3] + b[0] * b[0] + b[1] * b[1] + b[2] * b[2] + b[3] * b[3];
            ss = wave_sum(ss);
            const float r = rsqrtf(ss * (1.f / 512.f) + 1e-6f);
            const f32x4 g0 = *(const f32x4*)(p.q_norm + lane * 8), g1 = *(const f32x4*)(p.q_norm + lane * 8 + 4);
            uint4 o; o.x = cvt_pk_bf16(a[0] * r * g0[0], a[1] * r * g0[1]); o.y = cvt_pk_bf16(a[2] * r * g0[2], a[3] * r * g0[3]);
            o.z = cvt_pk_bf16(b[0] * r * g1[0], b[1] * r * g1[1]); o.w = cvt_pk_bf16(b[2] * r * g1[2], b[3] * r * g1[3]);
            *(uint4*)(CQN + (size_t)tok * 512 + lane * 8) = o;
        }
        {
            const f32x4 a = __builtin_nontemporal_load((const f32x4*)(srow + 544 + lane * 8)), b = __builtin_nontemporal_load((const f32x4*)(srow + 548 + lane * 8));
            float ss = a[0] * a[0] + a[1] * a[1] + a[2] * a[2] + a[3] * a[3] + b[0] * b[0] + b[1] * b[1] + b[2] * b[2] + b[3] * b[3];
            ss = wave_sum(ss);
            const float r = rsqrtf(ss * (1.f / 512.f) + 1e-6f);
            const f32x4 g0 = *(const f32x4*)(p.kv_norm + lane * 8), g1 = *(const f32x4*)(p.kv_norm + lane * 8 + 4);
            f32x4 ya, yb;
#pragma unroll
            for (int j = 0; j < 4; ++j) { ya[j] = a[j] * r * g0[j]; yb[j] = b[j] * r * g1[j]; }
            uint4 o; o.x = cvt_pk_bf16(ya[0], ya[1]); o.y = cvt_pk_bf16(ya[2], ya[3]); o.z = cvt_pk_bf16(yb[0], yb[1]); o.w = cvt_pk_bf16(yb[2], yb[3]);
            *(uint4*)(CKVA + (size_t)kr * 512 + lane * 8) = o;
            if (tok < NCTX) { float* op = p.out + OUT_CKV + (size_t)tok * 512 + lane * 8; *(f32x4*)op = ya; *(f32x4*)(op + 4) = yb; }
        }
        {
            const float v = srow[1056 + lane];
            if (tok < NCTX) { p.out[OUT_KROPE + (size_t)tok * 64 + lane] = v; KRA[(size_t)kr * 64 + lane] = f2bf(v); }
            else {
                const float pv = __shfl_xor(v, 16);
                const int it = (tok - NCTX) & 2047, axis = lane >> 5, half = (lane >> 4) & 1, fi = lane & 15;
                const int pos = axis == 0 ? (it >> 6) : (it & 63);
                const float cs = rope[(pos * 16 + fi) * 2], sn = rope[(pos * 16 + fi) * 2 + 1];
                const float o = half == 0 ? v * cs - pv * sn : v * cs + pv * sn;
                KRA[(size_t)kr * 64 + lane] = f2bf(o);
            }
        }
    }
}

__device__ __forceinline__ void gla_post_phase(const Params& p) {
    const int w = threadIdx.x >> 6, lane = threadIdx.x & 63;
    const bf16_t* OF = (const bf16_t*)(p.ws + WS_R2);
    const bf16_t* OB = OF + (size_t)TT * DM;
    const bf16_t* proj = (const bf16_t*)(p.ws + WS_R1);
    bf16_t* OG = (bf16_t*)(p.ws + WS_Q);
    const f32x4 gn0 = *(const f32x4*)(p.gla_norm + lane * 8), gn1 = *(const f32x4*)(p.gla_norm + lane * 8 + 4);
    for (int row = blockIdx.x * 8 + w; row < TT; row += gridDim.x * 8) {
#pragma unroll
        for (int h = 0; h < 4; ++h) {
            const size_t off = (size_t)row * DM + h * 512 + lane * 8;
            const u32x4 a = __builtin_nontemporal_load((const u32x4*)(OF + off)), b = __builtin_nontemporal_load((const u32x4*)(OB + off));
            const u32x4 rg = __builtin_nontemporal_load((const u32x4*)(proj + (size_t)row * PROJ_LD + 2048 + h * 512 + lane * 8));
            float o[8], g[8];
            o[0] = bflo(a.x) + bflo(b.x); o[1] = bfhi(a.x) + bfhi(b.x); o[2] = bflo(a.y) + bflo(b.y); o[3] = bfhi(a.y) + bfhi(b.y);
            o[4] = bflo(a.z) + bflo(b.z); o[5] = bfhi(a.z) + bfhi(b.z); o[6] = bflo(a.w) + bflo(b.w); o[7] = bfhi(a.w) + bfhi(b.w);
            g[0] = bflo(rg.x); g[1] = bfhi(rg.x); g[2] = bflo(rg.y); g[3] = bfhi(rg.y); g[4] = bflo(rg.z); g[5] = bfhi(rg.z); g[6] = bflo(rg.w); g[7] = bfhi(rg.w);
            float ss = 0.f;
#pragma unroll
            for (int j = 0; j < 8; ++j) ss += o[j] * o[j];
            ss = wave_sum(ss);
            const float r = rsqrtf(ss * (1.f / 512.f) + 1e-6f);
            float y[8];
#pragma unroll
            for (int j = 0; j < 8; ++j) y[j] = o[j] * r * (j < 4 ? gn0[j] : gn1[j - 4]) * siluf_(g[j]);
            uint4 ov; ov.x = cvt_pk_bf16(y[0], y[1]); ov.y = cvt_pk_bf16(y[2], y[3]); ov.z = cvt_pk_bf16(y[4], y[5]); ov.w = cvt_pk_bf16(y[6], y[7]);
            *(uint4*)(OG + off) = ov;
        }
    }
}

__device__ __forceinline__ void attn_item(const Params& p, unsigned char* ldsb, int s, int h, int qb) {
    int tid = threadIdx.x; asm volatile("" : "+v"(tid));
    const int w = tid >> 6, lane = tid & 63, lr = lane & 15, g = lane >> 4;
    int tok0, kr0, nkv;
    if (s < 16) { tok0 = s * 256; kr0 = s * 256; nkv = 256; } else { const int b = s - 16; tok0 = NCTX + b * 2048 + qb * 256; kr0 = NCTX + b * 2304; nkv = 2304; }
    const bf16_t* Q = (const bf16_t*)(p.ws + WS_Q);
    const bf16_t* KN = (const bf16_t*)(p.ws + WS_KN);
    const bf16_t* VT = (const bf16_t*)(p.ws + WS_VT);
    const bf16_t* KR = (const bf16_t*)(p.ws + WS_KRA);
    bf16_t* OM = (bf16_t*)(p.ws + WS_OM);
    bf16_t* lds = (bf16_t*)ldsb;
    constexpr int KST = 200, VST = 72, STAGE = 64 * KST + 128 * VST;
    bf16x8 Bq[2][6];
#pragma unroll
    for (int qf = 0; qf < 2; ++qf)
#pragma unroll
        for (int ks = 0; ks < 6; ++ks) Bq[qf][ks] = __builtin_nontemporal_load((const bf16x8*)(Q + (size_t)(tok0 + 32 * w + 16 * qf + lr) * 3072 + h * 192 + 32 * ks + 8 * g));
    f32x4 O[8][2];
#pragma unroll
    for (int df = 0; df < 8; ++df) { O[df][0] = (f32x4){0.f, 0.f, 0.f, 0.f}; O[df][1] = (f32x4){0.f, 0.f, 0.f, 0.f}; }
    float mrun[2] = {-1e30f, -1e30f}, lrun[2] = {0.f, 0.f}, mpend[2] = {-1e30f, -1e30f};
    const float cscale = 0.07216878364870322f * 1.4426950408889634f;
    uint4 rk0, rk1, rk2, rv0, rv1;
    const int nt = nkv / 64;
#define ATT_LK(i, dst, t) do { const int id = tid + 512 * (i), row = id / 24, c = id % 24; const size_t krw = (size_t)(kr0 + 64 * (t) + row); \
        const bf16_t* src = c < 16 ? KN + krw * 2048 + h * 128 + 8 * c : KR + krw * 64 + 8 * (c - 16); dst = *(const uint4*)src; } while (0)
#define ATT_LV(i, dst, t) do { const int id = tid + 512 * (i), dv = id >> 3, c = id & 7; dst = *(const uint4*)(VT + (size_t)(h * 128 + dv) * KVR + kr0 + 64 * (t) + 8 * c); } while (0)
#define ATT_LOAD(t) do { ATT_LK(0, rk0, t); ATT_LK(1, rk1, t); ATT_LK(2, rk2, t); ATT_LV(0, rv0, t); ATT_LV(1, rv1, t); } while (0)
#define ATT_SK(i, src_, Kb_) do { const int id = tid + 512 * (i), row = id / 24, c = id % 24; *(uint4*)((Kb_) + row * KST + 8 * c) = src_; } while (0)
#define ATT_SV(i, src_, Vb_) do { const int id = tid + 512 * (i), dv = id >> 3, c = id & 7; *(uint4*)((Vb_) + dv * VST + 8 * c) = src_; } while (0)
#define ATT_STORE(buf) do { bf16_t* Kb_ = lds + (buf) * STAGE; bf16_t* Vb_ = Kb_ + 64 * KST; ATT_SK(0, rk0, Kb_); ATT_SK(1, rk1, Kb_); ATT_SK(2, rk2, Kb_); ATT_SV(0, rv0, Vb_); ATT_SV(1, rv1, Vb_); } while (0)
    ATT_LOAD(0); ATT_STORE(0);
    __syncthreads();
    for (int t = 0; t < nt; ++t) {
        const bf16_t* Kb = lds + (t & 1) * STAGE; const bf16_t* Vb = Kb + 64 * KST;
        bf16_t* Kn = lds + ((t + 1) & 1) * STAGE; bf16_t* Vn = Kn + 64 * KST;
        const bool more = (t + 1 < nt);
        if (more) { ATT_LK(0, rk0, t + 1); ATT_LK(1, rk1, t + 1); ATT_LK(2, rk2, t + 1); }
        f32x4 st[4][2];
#pragma unroll
        for (int kf = 0; kf < 4; ++kf) { st[kf][0] = (f32x4){0.f, 0.f, 0.f, 0.f}; st[kf][1] = (f32x4){0.f, 0.f, 0.f, 0.f}; }
#pragma unroll
        for (int ks = 0; ks < 6; ++ks)
#pragma unroll
            for (int kf = 0; kf < 4; ++kf) {
                const bf16x8 a = *(const bf16x8*)(Kb + (16 * kf + lr) * KST + 32 * ks + 8 * g);
                st[kf][0] = __builtin_amdgcn_mfma_f32_16x16x32_bf16(a, Bq[0][ks], st[kf][0], 0, 0, 0);
                st[kf][1] = __builtin_amdgcn_mfma_f32_16x16x32_bf16(a, Bq[1][ks], st[kf][1], 0, 0, 0);
                if (kf & 1) __builtin_amdgcn_sched_barrier(0);
            }
        if (more) { ATT_SK(0, rk0, Kn); ATT_SK(1, rk1, Kn); ATT_SK(2, rk2, Kn); ATT_LV(0, rv0, t + 1); ATT_LV(1, rv1, t + 1); }
        bf16x8 Bp[2][2];
#pragma unroll
        for (int qf = 0; qf < 2; ++qf) {
            float mx = st[0][qf][0];
#pragma unroll
            for (int kf = 0; kf < 4; ++kf)
#pragma unroll
                for (int r = 0; r < 4; ++r) mx = fmaxf(mx, st[kf][qf][r]);
            mx = fmaxf(mx, __shfl_xor(mx, 16)); mx = fmaxf(mx, __shfl_xor(mx, 32));
            const float mnew = (t == 0) ? mx * cscale : fmaxf(mrun[qf], mpend[qf]);
            mpend[qf] = mx * cscale;
            const float alpha = __builtin_amdgcn_exp2f(mrun[qf] - mnew);
            mrun[qf] = mnew;
            float ps = 0.f; float pv[4][4];
#pragma unroll
            for (int kf = 0; kf < 4; ++kf)
#pragma unroll
                for (int r = 0; r < 4; ++r) { pv[kf][r] = __builtin_amdgcn_exp2f(st[kf][qf][r] * cscale - mnew); ps += pv[kf][r]; }
            lrun[qf] = lrun[qf] * alpha + ps;
#pragma unroll
            for (int df = 0; df < 8; ++df) O[df][qf] *= alpha;
#pragma unroll
            for (int s2 = 0; s2 < 2; ++s2) {
                union { bf16x8 v; unsigned u[4]; } pk;
                pk.u[0] = cvt_pk_bf16(pv[2 * s2][0], pv[2 * s2][1]); pk.u[1] = cvt_pk_bf16(pv[2 * s2][2], pv[2 * s2][3]);
                pk.u[2] = cvt_pk_bf16(pv[2 * s2 + 1][0], pv[2 * s2 + 1][1]); pk.u[3] = cvt_pk_bf16(pv[2 * s2 + 1][2], pv[2 * s2 + 1][3]);
                Bp[qf][s2] = pk.v;
            }
        }
#pragma unroll
        for (int s2 = 0; s2 < 2; ++s2)
#pragma unroll
            for (int df = 0; df < 8; ++df) {
                union { bf16x8 v; bf16x4 hh[2]; } a;
                a.hh[0] = *(const bf16x4*)(Vb + (16 * df + lr) * VST + 32 * s2 + 4 * g);
                a.hh[1] = *(const bf16x4*)(Vb + (16 * df + lr) * VST + 32 * s2 + 16 + 4 * g);
                O[df][0] = __builtin_amdgcn_mfma_f32_16x16x32_bf16(a.v, Bp[0][s2], O[df][0], 0, 0, 0);
                O[df][1] = __builtin_amdgcn_mfma_f32_16x16x32_bf16(a.v, Bp[1][s2], O[df][1], 0, 0, 0);
                if (df & 1) __builtin_amdgcn_sched_barrier(0);
            }
        if (more) { ATT_SV(0, rv0, Vn); ATT_SV(1, rv1, Vn); }
        __syncthreads();
    }
#undef ATT_LOAD
#undef ATT_STORE
#undef ATT_LK
#undef ATT_LV
#undef ATT_SK
#undef ATT_SV
    int tid2 = threadIdx.x; asm volatile("" : "+v"(tid2));
    const int w2 = tid2 >> 6, lr2 = tid2 & 15, g2 = (tid2 & 63) >> 4;
#pragma unroll
    for (int qf = 0; qf < 2; ++qf) {
        float l = lrun[qf]; l += __shfl_xor(l, 16); l += __shfl_xor(l, 32);
        const float inv = 1.f / l;
        bf16_t* op = OM + (size_t)(tok0 + 32 * w2 + 16 * qf + lr2) * DM + h * 128 + 4 * g2;
#pragma unroll
        for (int df = 0; df < 8; ++df) {
            uint2 o; o.x = cvt_pk_bf16(O[df][qf][0] * inv, O[df][qf][1] * inv); o.y = cvt_pk_bf16(O[df][qf][2] * inv, O[df][qf][3] * inv);
            *(uint2*)(op + 16 * df) = o;
        }
    }
}

__device__ __forceinline__ void gla_a_item(const Params& p, unsigned char* ldsb, int cg, int h, int dir) {
    int tid = threadIdx.x; asm volatile("" : "+v"(tid));
    const int w = tid >> 6, lane = tid & 63, lr = lane & 15, g = lane >> 4;
    const int c0 = cg * 64;
    const int it = (dir * 192 + cg) * 4 + h;
    const bf16_t* proj = (const bf16_t*)(p.ws + WS_R1);
    const bf16_t* VGT = (const bf16_t*)(p.ws + WS_VGT);
    const float* acmp = (const float*)(p.ws + WS_ACMP);
    bf16_t* OD = (bf16_t*)(p.ws + WS_R2) + (size_t)dir * TT * DM;
    bf16_t* QDg = (bf16_t*)(p.ws + WS_QD) + (size_t)it * 64 * 256;
    bf16_t* KITg = (bf16_t*)(p.ws + WS_KIT) + (size_t)it * 64 * 256;
    float* DECg = (float*)(p.ws + WS_DEC) + (size_t)it * 256;
    constexpr int QST = 264, TST = 72;
    bf16_t* qd = (bf16_t*)ldsb;
    bf16_t* kk = qd + 64 * QST;
    bf16_t* kinvT = kk + 64 * QST;
    bf16_t* vT = kinvT + 256 * TST;
    bf16_t* Amat = vT + 128 * TST;
    bf16_t* aop = Amat + 64 * TST;
    float* decay = (float*)(aop + 64 * TST);
    {
        uint4 rq0, rq1, rq2, rq3, rk0, rk1, rk2, rk3; f32x4 ra = (f32x4){0.f, 0.f, 0.f, 0.f};
#define GA_LQK(i, dq, dk) do { const int id = tid + 512 * (i), ir = id >> 5, c = id & 31; const size_t tok = (size_t)(c0 + (dir ? 63 - ir : ir)); \
        { const u32x4 tq_ = __builtin_nontemporal_load((const u32x4*)(proj + tok * PROJ_LD + h * 256 + 8 * c)), tk_ = __builtin_nontemporal_load((const u32x4*)(proj + tok * PROJ_LD + 1024 + h * 256 + 8 * c)); \
          dq = (uint4){tq_.x, tq_.y, tq_.z, tq_.w}; dk = (uint4){tk_.x, tk_.y, tk_.z, tk_.w}; } } while (0)
#define GA_SQK(i, sq, sk) do { const int id = tid + 512 * (i), ir = id >> 5, c = id & 31; *(uint4*)(qd + ir * QST + 8 * c) = sq; *(uint4*)(kk + ir * QST + 8 * c) = sk; } while (0)
        GA_LQK(0, rq0, rk0); GA_LQK(1, rq1, rk1); GA_LQK(2, rq2, rk2); GA_LQK(3, rq3, rk3);
        if (tid < 256) { const int ir = tid >> 2, r4 = tid & 3; ra = *(const f32x4*)(acmp + (size_t)(c0 + (dir ? 63 - ir : ir)) * 32 + dir * 16 + 4 * r4); }
        GA_SQK(0, rq0, rk0); GA_SQK(1, rq1, rk1); GA_SQK(2, rq2, rk2); GA_SQK(3, rq3, rk3);
#undef GA_LQK
#undef GA_SQK
        if (tid < 256) {
            const int ir = tid >> 2, r4 = tid & 3;
            uint2 hv, lv;
            hv.x = cvt_pk_bf16(ra[0], ra[1]); hv.y = cvt_pk_bf16(ra[2], ra[3]);
            lv.x = cvt_pk_bf16(ra[0] - bflo(hv.x), ra[1] - bfhi(hv.x)); lv.y = cvt_pk_bf16(ra[2] - bflo(hv.y), ra[3] - bfhi(hv.y));
            bf16_t* ap = aop + ir * TST + 4 * r4;
            *(uint2*)ap = hv; *(uint2*)(ap + 16) = lv; *(uint2*)(ap + 32) = hv; *(uint2*)(ap + 48) = (uint2){0u, 0u};
        }
    }
    __syncthreads();
#pragma unroll
    for (int kfi = 0; kfi < 2; ++kfi) {
        const int k = 16 * (2 * w + kfi) + lr;
        bf16x8 Wb0, Wb1;
        {
            union { bf16x8 v; unsigned u[4]; } hi, lo;
#pragma unroll
            for (int j2 = 0; j2 < 4; ++j2) {
                const float w0 = p.w_gla_alpha[((size_t)dir * 16 + ((8 * g + 2 * j2) & 15)) * 1024 + h * 256 + k];
                const float w1 = p.w_gla_alpha[((size_t)dir * 16 + ((8 * g + 2 * j2 + 1) & 15)) * 1024 + h * 256 + k];
                const unsigned hu = cvt_pk_bf16(w0, w1);
                hi.u[j2] = hu;
                lo.u[j2] = (g < 2) ? cvt_pk_bf16(w0 - bflo(hu), w1 - bfhi(hu)) : 0u;
            }
            Wb0 = hi.v; Wb1 = lo.v;
        }
        const float bias = p.b_gla_alpha[(size_t)dir * 1024 + h * 256 + k];
        f32x4 la[4];
#pragma unroll
        for (int tf = 0; tf < 4; ++tf) {
            f32x4 a = (f32x4){0.f, 0.f, 0.f, 0.f};
            a = __builtin_amdgcn_mfma_f32_16x16x32_bf16(*(const bf16x8*)(aop + (16 * tf + lr) * TST + 8 * g), Wb0, a, 0, 0, 0);
            a = __builtin_amdgcn_mfma_f32_16x16x32_bf16(*(const bf16x8*)(aop + (16 * tf + lr) * TST + 32 + 8 * g), Wb1, a, 0, 0, 0);
#pragma unroll
            for (int r = 0; r < 4; ++r) { const float x = a[r] + bias; la[tf][r] = (fminf(x, 0.f) - __logf(1.f + __expf(-fabsf(x)))) * (1.f / 16.f); }
        }
        float run = 0.f;
#pragma unroll
        for (int tf = 0; tf < 4; ++tf) {
            la[tf][1] += la[tf][0]; la[tf][2] += la[tf][1]; la[tf][3] += la[tf][2];
            const float tot = la[tf][3];
            const float t0 = __shfl(tot, lr), t1 = __shfl(tot, lr + 16), t2 = __shfl(tot, lr + 32), t3 = __shfl(tot, lr + 48);
            const float off = run + (g > 0 ? t0 : 0.f) + (g > 1 ? t1 : 0.f) + (g > 2 ? t2 : 0.f);
#pragma unroll
            for (int r = 0; r < 4; ++r) la[tf][r] += off;
            run += t0 + t1 + t2 + t3;
        }
        if (g == 3) { const float d = __expf(la[3][3]); decay[k] = d; DECg[k] = d; }
#pragma unroll
        for (int tf = 0; tf < 4; ++tf) {
            float ki[4];
#pragma unroll
            for (int r = 0; r < 4; ++r) {
                const int i = 16 * tf + 4 * g + r;
                const float b = la[tf][r];
                const float qv = bf2f(qd[i * QST + k]) * __expf(b) * (1.f / 16.f);
                ki[r] = bf2f(kk[i * QST + k]) * __expf(-b);
                qd[i * QST + k] = f2bf(qv);
                kk[i * QST + k] = f2bf(ki[r]);
            }
            uint2 o; o.x = cvt_pk_bf16(ki[0], ki[1]); o.y = cvt_pk_bf16(ki[2], ki[3]);
            *(uint2*)(kinvT + k * TST + 16 * tf + 4 * g) = o;
        }
    }
    __syncthreads();
#pragma unroll
    for (int ff = 0; ff < 2; ++ff) {
        const int f = 2 * w + ff, jf = f >> 2, iff = f & 3;
        f32x4 a = (f32x4){0.f, 0.f, 0.f, 0.f};
        if (jf <= iff) {
#pragma unroll
            for (int ks = 0; ks < 8; ++ks)
                a = __builtin_amdgcn_mfma_f32_16x16x32_bf16(*(const bf16x8*)(kk + (16 * jf + lr) * QST + 32 * ks + 8 * g), *(const bf16x8*)(qd + (16 * iff + lr) * QST + 32 * ks + 8 * g), a, 0, 0, 0);
            if (jf == iff) {
#pragma unroll
                for (int r = 0; r < 4; ++r) if (4 * g + r > lr) a[r] = 0.f;
            }
        }
        uint2 o; o.x = cvt_pk_bf16(a[0], a[1]); o.y = cvt_pk_bf16(a[2], a[3]);
        *(uint2*)(Amat + (16 * iff + lr) * TST + 16 * jf + 4 * g) = o;
    }
#pragma unroll
    for (int i = 0; i < 4; ++i) {
        const int id = tid + 512 * i;
        { const int ir = id >> 5, c = id & 31; *(uint4*)(QDg + (size_t)ir * 256 + 8 * c) = *(const uint4*)(qd + ir * QST + 8 * c); }
        { const int k = id >> 3, c = id & 7; *(uint4*)(KITg + (size_t)k * 64 + 8 * c) = *(const uint4*)(kinvT + k * TST + 8 * c); }
    }
    __syncthreads();
    {
        bf16_t* AMg = (bf16_t*)(p.ws + WS_AM) + (size_t)it * 4096;
        const int i = tid >> 3, c = tid & 7;
        *(uint4*)(AMg + i * 64 + 8 * c) = *(const uint4*)(Amat + i * TST + 8 * c);
    }
}

__device__ __forceinline__ void gla_b_unit(const Params& p, unsigned char* ldsb, int s, int h, int dir, int vs) {
    int tid0 = threadIdx.x; asm volatile("" : "+v"(tid0));
    const int w = tid0 >> 6, lane = tid0 & 63, lr = lane & 15, g = lane >> 4;
    const int nch = s < 16 ? 4 : 32;
    const int tb = s < 16 ? s * 256 : NCTX + (s - 16) * 2048;
    const bf16_t* VGT = (const bf16_t*)(p.ws + WS_VGT);
    const bf16_t* QDg = (const bf16_t*)(p.ws + WS_QD);
    const bf16_t* KITg = (const bf16_t*)(p.ws + WS_KIT);
    const float* DECg = (const float*)(p.ws + WS_DEC);
    const bf16_t* AMg = (const bf16_t*)(p.ws + WS_AM);
    bf16_t* OD = (bf16_t*)(p.ws + WS_R2) + (size_t)dir * TT * DM;
    constexpr int QST = 264, TST = 72;
    bf16_t* qd = (bf16_t*)ldsb;
    bf16_t* kinvT = qd + 64 * QST;
    bf16_t* vT = kinvT + 256 * TST;
    float* decay = (float*)(vT + 128 * TST);
    bf16_t* AmatL = (bf16_t*)(decay + 256);
    f32x4 S[16];
    const int vcol = vs * 128 + 16 * w + lr;
    if (s < 16) {
#pragma unroll
        for (int kf = 0; kf < 16; ++kf) S[kf] = (f32x4){0.f, 0.f, 0.f, 0.f};
    } else {
        const float* sp = (dir == 0 ? p.st_f : p.st_b) + ((size_t)((s - 16) * 4 + h) * 256) * 512 + vcol;
#pragma unroll
        for (int kf = 0; kf < 16; ++kf)
#pragma unroll
            for (int r = 0; r < 4; ++r) S[kf][r] = sp[(size_t)(16 * kf + 4 * g + r) * 512];
    }
    uint4 rq0, rq1, rq2, rq3, rk0, rk1, rk2, rk3, rv0, rv1, rm; float rd = 0.f;
#define GB_LOAD(ci_) do { int tid = threadIdx.x; asm volatile("" : "+v"(tid)); const int oc_ = dir ? nch - 1 - (ci_) : (ci_); const int c0_ = tb + oc_ * 64; const size_t it_ = (size_t)((dir * 192 + (c0_ >> 6)) * 4 + h); \
        rq0 = *(const uint4*)(QDg + it_ * 16384 + (size_t)(tid) * 8); rq1 = *(const uint4*)(QDg + it_ * 16384 + (size_t)(tid + 512) * 8); \
        rq2 = *(const uint4*)(QDg + it_ * 16384 + (size_t)(tid + 1024) * 8); rq3 = *(const uint4*)(QDg + it_ * 16384 + (size_t)(tid + 1536) * 8); \
        rk0 = *(const uint4*)(KITg + it_ * 16384 + (size_t)(tid) * 8); rk1 = *(const uint4*)(KITg + it_ * 16384 + (size_t)(tid + 512) * 8); \
        rk2 = *(const uint4*)(KITg + it_ * 16384 + (size_t)(tid + 1024) * 8); rk3 = *(const uint4*)(KITg + it_ * 16384 + (size_t)(tid + 1536) * 8); \
        { const int v = tid >> 3, c = tid & 7; rv0 = *(const uint4*)(VGT + (size_t)(h * 512 + vs * 128 + v) * TT + c0_ + 8 * c); rv1 = *(const uint4*)(VGT + (size_t)(h * 512 + vs * 128 + 64 + v) * TT + c0_ + 8 * c); } \
        rm = *(const uint4*)(AMg + it_ * 4096 + (size_t)tid * 8); \
        if (tid < 256) rd = DECg[it_ * 256 + tid]; } while (0)
#define GB_SQ(i, sq) do { const int id = tid + 512 * (i), ir = id >> 5, c = id & 31; *(uint4*)(qd + ir * QST + 8 * c) = sq; } while (0)
#define GB_SK(i, sk) do { const int id = tid + 512 * (i), k = id >> 3, c = id & 7; *(uint4*)(kinvT + k * TST + 8 * c) = sk; } while (0)
#define GB_SV(i, sv) do { const int id = tid + 512 * (i), v = id >> 3, c = id & 7; uint4 x = sv; \
        if (dir) { uint4 y; y.x = (x.w >> 16) | (x.w << 16); y.y = (x.z >> 16) | (x.z << 16); y.z = (x.y >> 16) | (x.y << 16); y.w = (x.x >> 16) | (x.x << 16); x = y; } \
        *(uint4*)(vT + v * TST + (dir ? 56 - 8 * c : 8 * c)) = x; } while (0)
    GB_LOAD(0);
    for (int ci = 0; ci < nch; ++ci) {
        const int oc = dir ? nch - 1 - ci : ci; const int c0 = tb + oc * 64;
        {
            int tid = threadIdx.x; asm volatile("" : "+v"(tid));
            GB_SQ(0, rq0); GB_SQ(1, rq1); GB_SQ(2, rq2); GB_SQ(3, rq3); GB_SK(0, rk0); GB_SK(1, rk1); GB_SK(2, rk2); GB_SK(3, rk3); GB_SV(0, rv0); GB_SV(1, rv1);
            *(uint4*)(AmatL + (tid >> 3) * TST + 8 * (tid & 7)) = rm;
            if (tid < 256) decay[tid] = rd;
        }
        __syncthreads();
        if (ci + 1 < nch) GB_LOAD(ci + 1);
        f32x4 oT[4];
#pragma unroll
        for (int iff = 0; iff < 4; ++iff) oT[iff] = (f32x4){0.f, 0.f, 0.f, 0.f};
#pragma unroll
        for (int s2 = 0; s2 < 8; ++s2) {
            union { bf16x8 v; unsigned u[4]; } sb;
            sb.u[0] = cvt_pk_bf16(S[2 * s2][0], S[2 * s2][1]); sb.u[1] = cvt_pk_bf16(S[2 * s2][2], S[2 * s2][3]);
            sb.u[2] = cvt_pk_bf16(S[2 * s2 + 1][0], S[2 * s2 + 1][1]); sb.u[3] = cvt_pk_bf16(S[2 * s2 + 1][2], S[2 * s2 + 1][3]);
#pragma unroll
            for (int iff = 0; iff < 4; ++iff) {
                union { bf16x8 v; bf16x4 hh[2]; } b;
                b.hh[0] = *(const bf16x4*)(qd + (16 * iff + lr) * QST + 32 * s2 + 4 * g);
                b.hh[1] = *(const bf16x4*)(qd + (16 * iff + lr) * QST + 32 * s2 + 16 + 4 * g);
                oT[iff] = __builtin_amdgcn_mfma_f32_16x16x32_bf16(sb.v, b.v, oT[iff], 0, 0, 0);
            }
            __builtin_amdgcn_sched_barrier(0);
        }
#pragma unroll
        for (int s2 = 0; s2 < 2; ++s2) {
            const bf16x8 a = *(const bf16x8*)(vT + (16 * w + lr) * TST + 32 * s2 + 8 * g);
#pragma unroll
            for (int iff = 0; iff < 4; ++iff)
                oT[iff] = __builtin_amdgcn_mfma_f32_16x16x32_bf16(a, *(const bf16x8*)(AmatL + (16 * iff + lr) * TST + 32 * s2 + 8 * g), oT[iff], 0, 0, 0);
        }
#pragma unroll
        for (int s2 = 0; s2 < 2; ++s2) {
            const bf16x8 b = *(const bf16x8*)(vT + (16 * w + lr) * TST + 32 * s2 + 8 * g);
#pragma unroll
            for (int kf = 0; kf < 16; ++kf)
            {
                S[kf] = __builtin_amdgcn_mfma_f32_16x16x32_bf16(*(const bf16x8*)(kinvT + (16 * kf + lr) * TST + 32 * s2 + 8 * g), b, S[kf], 0, 0, 0);
                if ((kf & 3) == 3) __builtin_amdgcn_sched_barrier(0);
            }
        }
#pragma unroll
        for (int kf = 0; kf < 16; ++kf) { const f32x4 d = *(const f32x4*)(decay + 16 * kf + 4 * g); S[kf] *= d; }
        asm volatile("s_waitcnt vmcnt(0)" ::: "memory");
#pragma unroll
        for (int iff = 0; iff < 4; ++iff) {
            const int i = 16 * iff + lr;
            const size_t tok = (size_t)(c0 + (dir ? 63 - i : i));
            uint2 o; o.x = cvt_pk_bf16(oT[iff][0], oT[iff][1]); o.y = cvt_pk_bf16(oT[iff][2], oT[iff][3]);
            *(uint2*)(OD + tok * DM + h * 512 + vs * 128 + 16 * w + 4 * g) = o;
        }
        __syncthreads();
    }
#undef GB_LOAD
#undef GB_SQ
#undef GB_SK
#undef GB_SV
    if (s < 16) {
        float* op = p.out + (dir == 0 ? OUT_SF : OUT_SB) + ((size_t)(s * 4 + h) * 256) * 512 + vcol;
#pragma unroll
        for (int kf = 0; kf < 16; ++kf)
#pragma unroll
            for (int r = 0; r < 4; ++r) op[(size_t)(16 * kf + 4 * g + r) * 512] = S[kf][r];
    }
}

__device__ __forceinline__ int queue_pop(const Params& p, unsigned char* lds, int q) {
    unsigned* cnt = (unsigned*)(p.ws + WS_CNT) + q;
    int* slot = (int*)(lds + LDS_BYTES - 16);
    __syncthreads();
    if (threadIdx.x == 0) *slot = (int)atomicAdd(cnt, 1u);
    __syncthreads();
    return *slot;
}
__device__ __forceinline__ void gla_a_phase(const Params& p, unsigned char* lds, int qi) {
    (void)qi;
    for (int it = blockIdx.x; it < 1536; it += gridDim.x) {
        __syncthreads();
        gla_a_item(p, lds, it >> 3, (it >> 1) & 3, it & 1);
    }
}
__device__ __forceinline__ void gla_b_phase(const Params& p, unsigned char* lds, int qi) {
    for (;;) {
        const int it = queue_pop(p, lds, qi);
        if (it >= 640) break;
        int s, h, dir, vs;
        if (it < 128) { s = 16 + (it >> 5); h = (it >> 3) & 3; dir = (it >> 2) & 1; vs = it & 3; }
        else { const int u = it - 128; s = u >> 5; h = (u >> 3) & 3; dir = (u >> 2) & 1; vs = u & 3; }
        gla_b_unit(p, lds, s, h, dir, vs);
    }
    for (;;) {
        const int t = queue_pop(p, lds, qi + 1);
        if (t >= 768) break;
        const int j = t >> 8, tt = t & 255;
        const float* src = j == 0 ? p.w_gla_out : (j == 1 ? p.w_mla_out : p.w_out);
        bf16_t* dst = (bf16_t*)(p.ws + (j == 0 ? WS_WT_G : (j == 1 ? WS_WT_M : WS_WT_OUT)));
        conv_tile((float*)lds, src, 2048, 2048, dst, 0, tt >> 5, tt & 31);
    }
}
__device__ __forceinline__ void attn_phase(const Params& p, unsigned char* lds, int qi = 1) {
    for (;;) {
        const int it = queue_pop(p, lds, qi);
        if (it >= 768) break;
        int s, h, qb;
        if (it < 512) { s = 16 + (it >> 7); h = (it >> 3) & 15; qb = it & 7; }
        else { const int u = it - 512; s = u >> 4; h = u & 15; qb = 0; }
        attn_item(p, lds, s, h, qb);
    }
}

#define XB_TMO      128
#define XB_XCNT(j)  (256  + 64 * (j))
#define XB_XSUB(j)  (1280 + 64 * (j))
#define XB_XGEN(j)  (2304 + 64 * (j))
#define XB_TOP      3328
#define XB_TOPGEN   3392
#define XCD_BAR_WORDS 3456
#define XB_SPIN_CAP (1u << 22)
__device__ __forceinline__ unsigned xb_ld(unsigned* p)              { return __hip_atomic_load(p, __ATOMIC_RELAXED, __HIP_MEMORY_SCOPE_AGENT); }
__device__ __forceinline__ unsigned xb_add(unsigned* p, unsigned v) { return __hip_atomic_fetch_add(p, v, __ATOMIC_RELAXED, __HIP_MEMORY_SCOPE_AGENT); }
__device__ __forceinline__ unsigned xb_xcc_id() { return (unsigned)__builtin_amdgcn_s_getreg((3 << 11) | 20) & 0xFu; }
#define XB_SPIN(cond, bar) do { unsigned _sp = 0; while (cond) { __builtin_amdgcn_s_sleep(1); \
    if ((++_sp & 255u) == 0u) { if (xb_ld(&(bar)[XB_TMO])) break; if (_sp > XB_SPIN_CAP) { atomicAdd(&(bar)[XB_TMO], 1u); break; } } } } while (0)
struct XcdBarrier { unsigned* bar; unsigned x; volatile LAS unsigned* st; };
__device__ __forceinline__ XcdBarrier xcd_barrier_post(unsigned* bar, volatile LAS unsigned* st) {
    XcdBarrier b; b.bar = bar; b.x = xb_xcc_id(); b.st = st;
    if (threadIdx.x == 0) (void)xb_add(&bar[XB_XCNT(b.x)], 1u);
    return b;
}
__device__ __forceinline__ void xcd_barrier_complete(unsigned* bar, unsigned x, unsigned& nloc, unsigned& nx) {
    const unsigned G = gridDim.x * gridDim.y * gridDim.z;
    unsigned sum, cnt, mine, sp = 0u;
    for (;;) {
        sum = 0u; cnt = 0u; mine = 0u;
#pragma unroll
        for (unsigned j = 0; j < 16; ++j) { const unsigned c = xb_ld(&bar[XB_XCNT(j)]); sum += c; cnt += (c > 0u) ? 1u : 0u; mine = (j == x) ? c : mine; }
        if (sum == G) break;
        __builtin_amdgcn_s_sleep(1);
        if ((++sp & 255u) == 0u) { if (xb_ld(&bar[XB_TMO])) break; if (sp > XB_SPIN_CAP) { atomicAdd(&bar[XB_TMO], 1u); break; } }
    }
    nloc = mine > 0u ? mine : 1u; nx = cnt > 0u ? cnt : 1u;
}
__device__ __forceinline__ void xcd_barrier(const XcdBarrier& b) {
    asm volatile("s_waitcnt vmcnt(0)" ::: "memory");
    __syncthreads();
    if (threadIdx.x == 0) {
        unsigned* bar = b.bar;
        __builtin_amdgcn_s_waitcnt(0);
        unsigned nloc = b.st[0], nx = b.st[1];
        if (nloc == 0u) { xcd_barrier_complete(bar, b.x, nloc, nx); b.st[0] = nloc; b.st[1] = nx; }
        const unsigned old = xb_add(&bar[XB_XSUB(b.x)], 1u);
        const unsigned gen = old / nloc;
        if (old + 1u == (gen + 1u) * nloc) {
            __builtin_amdgcn_fence(__ATOMIC_RELEASE, "agent");
            asm volatile("s_waitcnt vmcnt(0)" ::: "memory");
            const unsigned og = xb_add(&bar[XB_TOP], 1u);
            const unsigned tg = og / nx;
            if (og + 1u == (tg + 1u) * nx) xb_add(&bar[XB_TOPGEN], 1u);
            else XB_SPIN(xb_ld(&bar[XB_TOPGEN]) == tg, bar);
            __builtin_amdgcn_fence(__ATOMIC_ACQUIRE, "agent");
            xb_add(&bar[XB_XGEN(b.x)], 1u);
            asm volatile("s_waitcnt vmcnt(0)" ::: "memory");
        } else {
            XB_SPIN(xb_ld(&bar[XB_XGEN(b.x)]) == gen, bar);
            __builtin_amdgcn_fence(__ATOMIC_ACQUIRE, "agent");
            asm volatile("s_waitcnt vmcnt(0)" ::: "memory");
        }
    }
    __syncthreads();
}

__global__ void __launch_bounds__(512) fwd_megakernel(Params p) {
    __builtin_assume(__builtin_amdgcn_workitem_id_y() == 0);
    __builtin_assume(__builtin_amdgcn_workitem_id_z() == 0);
    extern __shared__ __attribute__((aligned(16))) unsigned char lds[];
    cg::grid_group grid = cg::this_grid();
    const int tid = threadIdx.x;
    bf16_t* ws16 = (bf16_t*)p.ws;
    volatile LAS unsigned* xst = (volatile LAS unsigned*)(LAS unsigned char*)(lds + LDS_BYTES - 32);
    if (tid == 0) { xst[0] = 0u; xst[1] = 0u; }
    __syncthreads();
    XcdBarrier xb; xb.bar = (unsigned*)(p.ws + WS_BAR); xb.x = 0; xb.st = xst;
    if (p.phase_hi - p.phase_lo > 1) xb = xcd_barrier_post((unsigned*)(p.ws + WS_BAR), xst);
    if ((ONLY_PHASE < 0 || ONLY_PHASE == 0) && p.phase_lo <= 0 && 0 < p.phase_hi)
    for (int rep_ = 0; rep_ < (PROBE_DUP == 0 ? 2 : 1); ++rep_) {
        if (rep_) xcd_barrier(xb);
        {
            if (blockIdx.x == 0 && tid < 8) ((unsigned*)(p.ws + WS_CNT))[tid] = 0u;
            for (int it = blockIdx.x; it < 288; it += gridDim.x) ada_item(p, (float*)lds, it);
            {
                float* rope = (float*)(p.ws + WS_ROPE);
                const int gi = blockIdx.x * 512 + tid;
                if (gi < 1024) {
                    const int pos = gi >> 4, fi = gi & 15;
                    const double invf = pow(10000.0, -(double)fi / 16.0);
                    const float ang = (float)pos * (float)invf;
                    rope[gi * 2] = (float)cos((double)ang); rope[gi * 2 + 1] = (float)sin((double)ang);
                }
            }
            int base = 288;
            conv_job((float*)lds, base, p.w_ffn1_in, 2048, 11008, (bf16_t*)(p.ws + WS_WT_FFN_IN), 11008, 1);
            conv_job((float*)lds, base, p.w_ffn1_out, 5504, 2048, (bf16_t*)(p.ws + WS_WT_FFN_OUT), 2048, 0);
            conv_job((float*)lds, base, p.w_in, 2048, 11360, (bf16_t*)(p.ws + WS_WT_IN), 11520, 0);
            conv_job((float*)lds, base, p.w_uq, 512, 3072, (bf16_t*)(p.ws + WS_WT_UQ), 3072, 0);
            conv_job((float*)lds, base, p.w_ukv, 512, 4096, (bf16_t*)(p.ws + WS_WT_UKV), 4096, 0);
        }
    }
    if (p.phase_lo <= 0 && 0 + 1 < p.phase_hi) xcd_barrier(xb);
    if (p.phase_lo == -12345) grid.sync();
    if ((ONLY_PHASE < 0 || ONLY_PHASE == 1) && p.phase_lo <= 1 && 1 < p.phase_hi)
    for (int rep_ = 0; rep_ < (PROBE_DUP == 1 ? 2 : 1); ++rep_) {
        if (rep_) xcd_barrier(xb);
        {
            const float* modp = (const float*)(p.ws + WS_MODP);
            float* mod = (float*)(p.ws + WS_MOD);
            for (int i = blockIdx.x * 512 + tid; i < 5 * 18432; i += gridDim.x * 512) {
                const int n = i % 18432;
                mod[i] = p.b_ada[n] + modp[i] + modp[i + 5 * 18432] + modp[i + 2 * 5 * 18432] + modp[i + 3 * 5 * 18432];
            }
        }
    }
    if (p.phase_lo <= 1 && 1 + 1 < p.phase_hi) xcd_barrier(xb);
    if ((ONLY_PHASE < 0 || ONLY_PHASE == 2) && p.phase_lo <= 2 && 2 < p.phase_hi)
    for (int rep_ = 0; rep_ < (PROBE_DUP == 2 ? 2 : 1); ++rep_) {
        if (rep_) xcd_barrier(xb);
        row_phase(p, 1);
    }
    if (p.phase_lo <= 2 && 2 + 1 < p.phase_hi) xcd_barrier(xb);
    if ((ONLY_PHASE < 0 || ONLY_PHASE == 3) && p.phase_lo <= 3 && 3 < p.phase_hi)
    for (int rep_ = 0; rep_ < (PROBE_DUP == 3 ? 2 : 1); ++rep_) {
        if (rep_) xcd_barrier(xb);
        { EpiSwiglu e{(bf16_t*)(p.ws + WS_R1)}; run_gemm(lds, (const bf16_t*)(p.ws + WS_H), (const bf16_t*)(p.ws + WS_WT_FFN_IN), TT, 11008, 2048, e); }
    }
    if (p.phase_lo <= 3 && 3 + 1 < p.phase_hi) xcd_barrier(xb);
    if ((ONLY_PHASE < 0 || ONLY_PHASE == 4) && p.phase_lo <= 4 && 4 < p.phase_hi)
    for (int rep_ = 0; rep_ < (PROBE_DUP == 4 ? 2 : 1); ++rep_) {
        if (rep_) xcd_barrier(xb);
        { EpiF32 e{(bf16_t*)(p.ws + WS_R2), DM, (bf16_t*)(p.ws + WS_Y1)}; run_gemm(lds, (const bf16_t*)(p.ws + WS_R1), (const bf16_t*)(p.ws + WS_WT_FFN_OUT), TT, 2048, DFF, e, 2); }
    }
    if (p.phase_lo <= 4 && 4 + 1 < p.phase_hi) xcd_barrier(xb);
    if ((ONLY_PHASE < 0 || ONLY_PHASE == 5) && p.phase_lo <= 5 && 5 < p.phase_hi)
    for (int rep_ = 0; rep_ < (PROBE_DUP == 5 ? 2 : 1); ++rep_) {
        if (rep_) xcd_barrier(xb);
        row_phase(p, 2);
    }
    if (p.phase_lo <= 5 && 5 + 1 < p.phase_hi) xcd_barrier(xb);
    if ((ONLY_PHASE < 0 || ONLY_PHASE == 6) && p.phase_lo <= 6 && 6 < p.phase_hi)
    for (int rep_ = 0; rep_ < (PROBE_DUP == 6 ? 2 : 1); ++rep_) {
        if (rep_) xcd_barrier(xb);
        { EpiProj e{(bf16_t*)(p.ws + WS_R1), (bf16_t*)(p.ws + WS_VGT), (float*)(p.ws + WS_SMALL)}; run_gemm(lds, (const bf16_t*)(p.ws + WS_H), (const bf16_t*)(p.ws + WS_WT_IN), TT, 11520, 2048, e); }
    }
    if (p.phase_lo <= 6 && 6 + 1 < p.phase_hi) xcd_barrier(xb);
    if ((ONLY_PHASE < 0 || ONLY_PHASE == 7) && p.phase_lo <= 7 && 7 < p.phase_hi)
    for (int rep_ = 0; rep_ < (PROBE_DUP == 7 ? 2 : 1); ++rep_) {
        if (rep_) xcd_barrier(xb);
        {
            token_phase(p);
        }
    }
    if (p.phase_lo <= 7 && 7 + 1 < p.phase_hi) xcd_barrier(xb);
    if ((ONLY_PHASE < 0 || ONLY_PHASE == 8) && p.phase_lo <= 8 && 8 < p.phase_hi)
    for (int rep_ = 0; rep_ < (PROBE_DUP == 8 ? 2 : 1); ++rep_) {
        if (rep_) xcd_barrier(xb);
        { EpiQ e{(bf16_t*)(p.ws + WS_Q), (const float*)(p.ws + WS_ROPE)}; run_gemm(lds, (const bf16_t*)(p.ws + WS_CQN), (const bf16_t*)(p.ws + WS_WT_UQ), TT, 3072, 512, e); }
    }
    if (p.phase_lo <= 8 && 8 + 1 < p.phase_hi) xcd_barrier(xb);
    if ((ONLY_PHASE < 0 || ONLY_PHASE == 9) && p.phase_lo <= 9 && 9 < p.phase_hi)
    for (int rep_ = 0; rep_ < (PROBE_DUP == 9 ? 2 : 1); ++rep_) {
        if (rep_) xcd_barrier(xb);
        { EpiKV e{(bf16_t*)(p.ws + WS_KN), (bf16_t*)(p.ws + WS_VT)}; run_gemm(lds, (const bf16_t*)(p.ws + WS_CKVA), (const bf16_t*)(p.ws + WS_WT_UKV), KVR, 4096, 512, e); }
    }
    if (p.phase_lo <= 9 && 9 + 1 < p.phase_hi) xcd_barrier(xb);
    if ((ONLY_PHASE < 0 || ONLY_PHASE == 10) && p.phase_lo <= 10 && 10 < p.phase_hi)
    for (int rep_ = 0; rep_ < (PROBE_DUP == 10 ? 2 : 1); ++rep_) {
        if (rep_) xcd_barrier(xb);
        attn_phase(p, lds, rep_ ? 5 : 1);
    }
    if (p.phase_lo <= 10 && 10 + 1 < p.phase_hi) xcd_barrier(xb);
    if ((ONLY_PHASE < 0 || ONLY_PHASE == 11) && p.phase_lo <= 11 && 11 < p.phase_hi)
    for (int rep_ = 0; rep_ < (PROBE_DUP == 11 ? 2 : 1); ++rep_) {
        if (rep_) xcd_barrier(xb);
        gla_a_phase(p, lds, rep_ ? 4 : 0);
    }
    if (p.phase_lo <= 11 && 11 + 1 < p.phase_hi) xcd_barrier(xb);
    if ((ONLY_PHASE < 0 || ONLY_PHASE == 12) && p.phase_lo <= 12 && 12 < p.phase_hi)
    for (int rep_ = 0; rep_ < (PROBE_DUP == 12 ? 2 : 1); ++rep_) {
        if (rep_) xcd_barrier(xb);
        gla_b_phase(p, lds, rep_ ? 6 : 2);
    }
    if (p.phase_lo <= 12 && 12 + 1 < p.phase_hi) xcd_barrier(xb);
    if ((ONLY_PHASE < 0 || ONLY_PHASE == 13) && p.phase_lo <= 13 && 13 < p.phase_hi)
    for (int rep_ = 0; rep_ < (PROBE_DUP == 13 ? 2 : 1); ++rep_) {
        if (rep_) xcd_barrier(xb);
        gla_post_phase(p);
    }
    if (p.phase_lo <= 13 && 13 + 1 < p.phase_hi) xcd_barrier(xb);
    if ((ONLY_PHASE < 0 || ONLY_PHASE == 14) && p.phase_lo <= 14 && 14 < p.phase_hi)
    for (int rep_ = 0; rep_ < (PROBE_DUP == 14 ? 2 : 1); ++rep_) {
        if (rep_) xcd_barrier(xb);
        { EpiGate e{(const bf16_t*)(p.ws + WS_R1), (bf16_t*)(p.ws + WS_H)}; run_gemm(lds, (const bf16_t*)(p.ws + WS_Q), (const bf16_t*)(p.ws + WS_WT_G), TT, 2048, 2048, e, 1, (const bf16_t*)(p.ws + WS_OM), (const bf16_t*)(p.ws + WS_WT_M)); }
        {
            const int G = gridDim.x, nfull = 384 - G > 0 ? 384 - G : 0;
            int wb = (int)blockIdx.x - nfull, nw = G - nfull;
            if (nw <= 0) { wb = blockIdx.x; nw = G; }
            if (wb >= 0) {
                int base = 0;
                conv_job((float*)lds, base, p.w_ffn2_in, 2048, 11008, (bf16_t*)(p.ws + WS_WT_FFN_IN), 11008, 1, wb, nw);
                conv_job((float*)lds, base, p.w_ffn2_out, 5504, 2048, (bf16_t*)(p.ws + WS_WT_FFN_OUT), 2048, 0, wb, nw);
            }
        }
    }
    if (p.phase_lo <= 14 && 14 + 1 < p.phase_hi) xcd_barrier(xb);
    if ((ONLY_PHASE < 0 || ONLY_PHASE == 15) && p.phase_lo <= 15 && 15 < p.phase_hi)
    for (int rep_ = 0; rep_ < (PROBE_DUP == 15 ? 2 : 1); ++rep_) {
        if (rep_) xcd_barrier(xb);
        { EpiF32 e{(bf16_t*)(p.ws + WS_R2), DM, (bf16_t*)(p.ws + WS_Y1)}; run_gemm(lds, (const bf16_t*)(p.ws + WS_H), (const bf16_t*)(p.ws + WS_WT_OUT), TT, 2048, 2048, e, 2); }
    }
    if (p.phase_lo <= 15 && 15 + 1 < p.phase_hi) xcd_barrier(xb);
    if ((ONLY_PHASE < 0 || ONLY_PHASE == 16) && p.phase_lo <= 16 && 16 < p.phase_hi)
    for (int rep_ = 0; rep_ < (PROBE_DUP == 16 ? 2 : 1); ++rep_) {
        if (rep_) xcd_barrier(xb);
        row_phase(p, 3);
    }
    if (p.phase_lo <= 16 && 16 + 1 < p.phase_hi) xcd_barrier(xb);
    if ((ONLY_PHASE < 0 || ONLY_PHASE == 17) && p.phase_lo <= 17 && 17 < p.phase_hi)
    for (int rep_ = 0; rep_ < (PROBE_DUP == 17 ? 2 : 1); ++rep_) {
        if (rep_) xcd_barrier(xb);
        { EpiSwiglu e{(bf16_t*)(p.ws + WS_R1)}; run_gemm(lds, (const bf16_t*)(p.ws + WS_H), (const bf16_t*)(p.ws + WS_WT_FFN_IN), TT, 11008, 2048, e); }
    }
    if (p.phase_lo <= 17 && 17 + 1 < p.phase_hi) xcd_barrier(xb);
    if ((ONLY_PHASE < 0 || ONLY_PHASE == 18) && p.phase_lo <= 18 && 18 < p.phase_hi)
    for (int rep_ = 0; rep_ < (PROBE_DUP == 18 ? 2 : 1); ++rep_) {
        if (rep_) xcd_barrier(xb);
        { EpiF32 e{(bf16_t*)(p.ws + WS_R2), DM, (bf16_t*)(p.ws + WS_Y1)}; run_gemm(lds, (const bf16_t*)(p.ws + WS_R1), (const bf16_t*)(p.ws + WS_WT_FFN_OUT), TT, 2048, DFF, e, 2); }
    }
    if (p.phase_lo <= 18 && 18 + 1 < p.phase_hi) xcd_barrier(xb);
    if ((ONLY_PHASE < 0 || ONLY_PHASE == 19) && p.phase_lo <= 19 && 19 < p.phase_hi)
    for (int rep_ = 0; rep_ < (PROBE_DUP == 19 ? 2 : 1); ++rep_) {
        if (rep_) xcd_barrier(xb);
        row_phase(p, 4);
    }
    (void)ws16;
}

extern "C" void kernel_launch(void* const* d_in, const int* in_sizes, int n_in, void* d_out, int out_size, void* d_ws, size_t ws_size, hipStream_t stream) {
    (void)in_sizes; (void)n_in; (void)out_size;
    static int grid_blocks = 0;
    if (!grid_blocks) {
        hipFuncSetAttribute((const void*)fwd_megakernel, hipFuncAttributeMaxDynamicSharedMemorySize, LDS_BYTES);
        int dev = 0, cus = 0, per_cu = 0;
        hipGetDevice(&dev);
        hipDeviceGetAttribute(&cus, hipDeviceAttributeMultiprocessorCount, dev);
        hipOccupancyMaxActiveBlocksPerMultiprocessor(&per_cu, fwd_megakernel, 512, LDS_BYTES);
        if (per_cu < 1) per_cu = 1;
        grid_blocks = cus * 1;
    }
    if (ws_size < WS_END) { fprintf(stderr, "workspace too small: %zu < %zu\n", ws_size, (size_t)WS_END); return; }
    Params p{};
    const float* const* in = (const float* const*)d_in;
    p.x_prompt = in[0]; p.x_sample = in[1]; p.cache_ckv = in[2]; p.cache_krope = in[3]; p.st_f = in[4]; p.st_b = in[5]; p.c = in[6]; p.c_ctx = in[7];
    p.w_ada = in[8]; p.b_ada = in[9]; p.norm_gains = in[10]; p.w_ffn1_in = in[11]; p.w_ffn1_out = in[12]; p.w_ffn2_in = in[13]; p.w_ffn2_out = in[14];
    p.w_in = in[15]; p.w_gla_alpha = in[16]; p.b_gla_alpha = in[17]; p.gla_norm = in[18]; p.w_gla_out = in[19]; p.q_norm = in[20]; p.kv_norm = in[21];
    p.w_uq = in[22]; p.w_ukv = in[23]; p.w_mla_out = in[24]; p.w_out = in[25];
    p.out = (float*)d_out; p.ws = (char*)d_ws;
#if N_LAUNCH_SPLIT
    for (int ph = 0; ph < NPHASE; ++ph) {
        p.phase_lo = ph; p.phase_hi = ph + 1;
        hipLaunchKernelGGL(fwd_megakernel, dim3(grid_blocks), dim3(512), LDS_BYTES, stream, p);
    }
#else
    p.phase_lo = 0; p.phase_hi = NPHASE;
    (void)hipMemsetAsync((char*)d_ws + WS_BAR, 0, XCD_BAR_WORDS * 4, stream);
    void* args[] = {&p};
    hipError_t e = hipLaunchCooperativeKernel((const void*)fwd_megakernel, dim3(grid_blocks), dim3(512), args, LDS_BYTES, stream);
    if (e != hipSuccess) fprintf(stderr, "cooperative launch failed: %s (grid %d)\n", hipGetErrorString(e), grid_blocks);
#endif
}
```

```cpp
#include <hip/hip_runtime.h>
#include <hip/hip_cooperative_groups.h>
#include <cstdio>
namespace cg = cooperative_groups;

typedef unsigned short bf16_t;
typedef short bf16x8 __attribute__((ext_vector_type(8)));
typedef short bf16x4 __attribute__((ext_vector_type(4)));
typedef float f32x4 __attribute__((ext_vector_type(4)));
typedef unsigned u32x2 __attribute__((ext_vector_type(2)));
typedef unsigned u32x4 __attribute__((ext_vector_type(4)));
#define LAS __attribute__((address_space(3)))

#ifndef ONLY_PHASE
#define ONLY_PHASE -1
#endif
#ifndef PROBE_DUP
#define PROBE_DUP -1
#endif
#ifndef N_LAUNCH_SPLIT
#define N_LAUNCH_SPLIT 0
#endif

constexpr int TT = 12288;
constexpr int NCTX = 4096;
constexpr int DM = 2048;
constexpr int DFF = 5504;
constexpr int KVR = 13312;
constexpr int PROJ_LD = 8192;
constexpr int SMALL_LD = 1120;
constexpr int NPHASE = 20;
constexpr int LDS_BYTES = 147456;

constexpr size_t OUT_Y = 0, OUT_CKV = 25165824, OUT_KROPE = 27262976, OUT_SF = 27525120, OUT_SB = 35913728;

constexpr size_t WS_WT_FFN_IN = 0;
constexpr size_t WS_WT_FFN_OUT = WS_WT_FFN_IN + (size_t)11008 * 2048 * 2;
constexpr size_t WS_WT_IN = WS_WT_FFN_OUT + (size_t)2048 * 5504 * 2;
constexpr size_t WS_WT_G = WS_WT_IN + (size_t)11520 * 2048 * 2;
constexpr size_t WS_WT_M = WS_WT_G + (size_t)2048 * 2048 * 2;
constexpr size_t WS_WT_UQ = WS_WT_M + (size_t)2048 * 2048 * 2;
constexpr size_t WS_WT_UKV = WS_WT_UQ + (size_t)3072 * 512 * 2;
constexpr size_t WS_WT_OUT = WS_WT_UKV + (size_t)4096 * 512 * 2;
constexpr size_t WS_MODP = WS_WT_OUT + (size_t)2048 * 2048 * 2;
constexpr size_t WS_MOD = WS_MODP + (size_t)4 * 5 * 18432 * 4;
constexpr size_t WS_ROPE = WS_MOD + (size_t)5 * 18432 * 4;
constexpr size_t WS_CNT = WS_ROPE + 8192;
constexpr size_t WS_BAR = WS_CNT + 256;
constexpr size_t WS_H = WS_BAR + 13824;
constexpr size_t WS_CQN = WS_H;
constexpr size_t WS_CKVA = WS_CQN + (size_t)TT * 512 * 2;
constexpr size_t WS_KRA = WS_CKVA + (size_t)KVR * 512 * 2;
constexpr size_t WS_ACMP = WS_KRA + (size_t)KVR * 64 * 2;
constexpr size_t WS_R1 = WS_H + (size_t)TT * 2048 * 2;
constexpr size_t WS_R2 = WS_R1 + (size_t)TT * PROJ_LD * 2;
constexpr size_t WS_SMALL = WS_R2 + (size_t)TT * 2048 * 4;
constexpr size_t WS_Q = WS_SMALL + (size_t)TT * SMALL_LD * 4;
constexpr size_t WS_VGT = WS_Q + (size_t)TT * 3072 * 2;
constexpr size_t WS_OM = WS_SMALL;
constexpr size_t WS_KN = 0;
constexpr size_t WS_VT = WS_KN + (size_t)KVR * 2048 * 2;
static_assert(WS_VT + (size_t)KVR * 2048 * 2 <= WS_WT_G, "KN/VT alias region");
constexpr size_t WS_Y1 = WS_R2 + (size_t)TT * 2048 * 2;
constexpr size_t WS_QD = 0;
constexpr size_t WS_KIT = WS_QD + (size_t)1536 * 64 * 256 * 2;
constexpr size_t WS_DEC = WS_KIT + (size_t)1536 * 64 * 256 * 2;
constexpr size_t WS_AM = WS_DEC + (size_t)1536 * 256 * 4;
static_assert(WS_AM + (size_t)1536 * 64 * 64 * 2 <= WS_WT_G, "GLA intermediates alias region");
static_assert(WS_ACMP + (size_t)TT * 32 * 4 <= WS_R1, "H alias region");
constexpr size_t WS_END = WS_VGT + (size_t)TT * 2048 * 2;

struct Params {
    const float *x_prompt, *x_sample, *cache_ckv, *cache_krope, *st_f, *st_b, *c, *c_ctx, *w_ada, *b_ada, *norm_gains,
        *w_ffn1_in, *w_ffn1_out, *w_ffn2_in, *w_ffn2_out, *w_in, *w_gla_alpha, *b_gla_alpha, *gla_norm, *w_gla_out,
        *q_norm, *kv_norm, *w_uq, *w_ukv, *w_mla_out, *w_out;
    float* out;
    char* ws;
    int phase_lo, phase_hi;
};

__device__ __forceinline__ unsigned cvt_pk_bf16(float lo, float hi) { unsigned r; asm volatile("v_cvt_pk_bf16_f32 %0, %1, %2" : "=v"(r) : "v"(lo), "v"(hi)); return r; }
__device__ __forceinline__ bf16_t f2bf(float f) { unsigned u = __float_as_uint(f); u += 0x7FFFu + ((u >> 16) & 1u); return (bf16_t)(u >> 16); }
__device__ __forceinline__ float bf2f(bf16_t h) { return __uint_as_float(((unsigned)h) << 16); }
__device__ __forceinline__ float bflo(unsigned u) { return __uint_as_float(u << 16); }
__device__ __forceinline__ float bfhi(unsigned u) { return __uint_as_float(u & 0xffff0000u); }
__device__ __forceinline__ float wave_sum(float v) {
#pragma unroll
    for (int o = 32; o > 0; o >>= 1) v += __shfl_xor(v, o);
    return v;
}
__device__ __forceinline__ float sigmoidf_(float x) { return __builtin_amdgcn_rcpf(1.f + __expf(-x)); }
__device__ __forceinline__ float siluf_(float x) { return x * __builtin_amdgcn_rcpf(1.f + __expf(-x)); }

namespace pg8 {
constexpr int BM = 256, BK = 64, HALF = 128, HTB = HALF * BK * 2, NXCD = 8, WGM = 8;
__device__ __forceinline__ int lds_byte(int r, int c) { const int st = (r >> 4) * 2 + (c >> 5), rr = r & 15, cc = c & 31, ob = rr * 64 + cc * 2; return st * 1024 + (ob ^ (((ob >> 9) & 1) << 5)); }
__device__ __forceinline__ void stage_rc(int b, int& R, int& C) { const int st = b / 1024, sb = b % 1024, swz = sb ^ (((sb >> 9) & 1) << 5); R = (st >> 1) * 16 + swz / 64; C = (st & 1) * 32 + (swz % 64) / 2; }
struct Unit { int pm, pn, ks, koff, nt, seg; };
struct Gemm { const bf16_t* A; const bf16_t* Bt; int M, N, K; const bf16_t* A1; const bf16_t* Bt1; };
struct StaticOrder {
    int nM, nN, nwg, G, c, nt0, nt1, nsplit, nseg;
    __device__ void init(int M, int N, int K, int G_, int c_, int split, int nseg_ = 1) {
        nM = M / BM; nN = N / BM; nwg = nM * nN; G = G_; c = c_; nsplit = split; nseg = nseg_;
        const int ntk = K / BK;
        if (split == 2) { nt0 = ((ntk / 2) + 1) & ~1; nt1 = ntk - nt0; } else { nt0 = ntk; nt1 = 0; }
    }
    __device__ bool next(int i, Unit& u) const {
        u.seg = 0; if (nseg == 2) { u.seg = i & 1; i >>= 1; }
        long L = (long)i * G + c; if (L >= (long)nwg * nsplit) return false;
        u.ks = L >= nwg ? 1 : 0; if (u.ks) L -= nwg;
        u.koff = u.ks ? nt0 * BK : 0; u.nt = u.ks ? nt1 : nt0;
        int wgid = (int)L; { const int q = nwg / NXCD, r = nwg % NXCD, xcd = wgid % NXCD, off = wgid / NXCD; wgid = (xcd < r ? xcd * (q + 1) : r * (q + 1) + (xcd - r) * q) + off; }
        const int nig = WGM * nN, gid = wgid / nig, fm = gid * WGM, gsz = (nM - fm) < WGM ? (nM - fm) : WGM;
        u.pm = fm + ((wgid % nig) % gsz); u.pn = (wgid % nig) / gsz; return true;
    }
};
template <class Epi>
__device__ __forceinline__ void gemm_phase(LAS unsigned char* lds, const Gemm g, const StaticOrder& S, const Epi& E) {
    const int tid = threadIdx.x, wid = __builtin_amdgcn_readfirstlane(tid >> 6), lane = tid & 63, wr = wid >> 2, wc = wid & 3, fr = lane & 15, fq = lane >> 4;
    const int K = g.K;
    unsigned voffA[2];
#pragma unroll
    for (int i = 0; i < 2; ++i) { int R, C; stage_rc(tid * 16 + i * 8192, R, C); voffA[i] = (unsigned)(R * K + C) * 2u; }
    const size_t kstep = (size_t)(BK * 2);
    const size_t hstep = (size_t)HALF * K * 2;
    const size_t tstep = 2 * hstep;
    const unsigned ldsw = (unsigned)wid * 1024u;
    const int aoff = lds_byte(wr * 64 + fr, fq * 8), boff = lds_byte(wc * 32 + fr, fq * 8);
#define PG8_SA(b, h) (((b) * 2 + (h)) * HTB)
#define PG8_SB(b, h) ((4 + (b) * 2 + (h)) * HTB)
#define PG8_STAGE(bufoff, gbase, voff) do { _Pragma("unroll") for (int _i = 0; _i < 2; ++_i) \
        __builtin_amdgcn_global_load_lds((const unsigned*)((const char*)(gbase) + (voff)[_i]), (LAS unsigned*)(lds + (bufoff) + ldsw + _i * 8192), 16, 0, 0); } while (0)
#define PG8_LDA(dst, b, h) do { _Pragma("unroll") for (int m = 0; m < 4; ++m) _Pragma("unroll") for (int k = 0; k < 2; ++k) dst[m][k] = *(const LAS bf16x8*)(lds + PG8_SA(b, h) + aoff + m * 2048 + k * 1024); } while (0)
#define PG8_LDB(dst, b, h) do { _Pragma("unroll") for (int n = 0; n < 2; ++n) _Pragma("unroll") for (int k = 0; k < 2; ++k) dst[n][k] = *(const LAS bf16x8*)(lds + PG8_SB(b, h) + boff + n * 2048 + k * 1024); } while (0)
#define PG8_MMA(ai, bj, At, Bt) do { __builtin_amdgcn_s_setprio(1); _Pragma("unroll") for (int m = 0; m < 4; ++m) _Pragma("unroll") for (int n = 0; n < 2; ++n) _Pragma("unroll") for (int k = 0; k < 2; ++k) \
        acc[ai][bj][m][n] = __builtin_amdgcn_mfma_f32_16x16x32_bf16(Bt[n][k], At[m][k], acc[ai][bj][m][n], 0, 0, 0); __builtin_amdgcn_s_setprio(0); } while (0)
#define PG8_WAIT_V(n) asm volatile("s_waitcnt vmcnt(" #n ")" ::: "memory")
#define PG8_WAIT_L(n) asm volatile("s_waitcnt lgkmcnt(" #n ")" ::: "memory")
#define PG8_BAR __builtin_amdgcn_s_barrier()
#define PG8_SCHED __builtin_amdgcn_sched_barrier(0)
    Unit cur, nxt; int ui = 0;
    if (!S.next(0, cur)) return;
    f32x4 acc[2][2][4][2];
#pragma unroll
    for (int a = 0; a < 2; ++a)
#pragma unroll
        for (int b = 0; b < 2; ++b)
#pragma unroll
            for (int m = 0; m < 4; ++m)
#pragma unroll
                for (int n = 0; n < 2; ++n) acc[a][b][m][n] = (f32x4){0.f, 0.f, 0.f, 0.f};
    bf16x8 At[4][2], B0[2][2], B1[2][2];
    const char* cA = (const char*)(cur.seg ? g.A1 : g.A) + (size_t)cur.pm * tstep + (size_t)cur.koff * 2; const char* cB = (const char*)(cur.seg ? g.Bt1 : g.Bt) + (size_t)cur.pn * tstep + (size_t)cur.koff * 2;
    PG8_STAGE(PG8_SB(0, 0), cB, voffA); PG8_STAGE(PG8_SA(0, 0), cA, voffA); PG8_STAGE(PG8_SB(0, 1), cB + hstep, voffA); PG8_STAGE(PG8_SA(0, 1), cA + hstep, voffA);
    if (wr == 1) PG8_BAR;
    PG8_WAIT_V(4); PG8_BAR;
    PG8_STAGE(PG8_SB(1, 0), cB + kstep, voffA); PG8_STAGE(PG8_SA(1, 0), cA + kstep, voffA); PG8_STAGE(PG8_SB(1, 1), cB + hstep + kstep, voffA);
    PG8_WAIT_V(6); PG8_BAR;
    for (;;) {
        const bool has_next = S.next(ui + 1, nxt);
        const char* nA = has_next ? (const char*)(nxt.seg ? g.A1 : g.A) + (size_t)nxt.pm * tstep + (size_t)nxt.koff * 2 : cA; const char* nB = has_next ? (const char*)(nxt.seg ? g.Bt1 : g.Bt) + (size_t)nxt.pn * tstep + (size_t)nxt.koff * 2 : cB;
        const int nt = cur.nt;
        for (int t = 0; t < nt; t += 2) {
            const bool last = (t == nt - 2);
            const char* a1 = cA + (size_t)(t + 1) * kstep;
            const char* a2 = last ? nA : cA + (size_t)(t + 2) * kstep; const char* b2 = last ? nB : cB + (size_t)(t + 2) * kstep;
            const char* a3 = a2 + kstep; const char* b3 = b2 + kstep;
            PG8_LDB(B0, 0, 0); PG8_SCHED; PG8_LDA(At, 0, 0); PG8_STAGE(PG8_SA(1, 1), a1 + hstep, voffA);
            PG8_WAIT_L(8); PG8_BAR; PG8_WAIT_L(0); PG8_MMA(0, 0, At, B0); PG8_BAR; PG8_SCHED;
            PG8_LDB(B1, 0, 1); PG8_STAGE(PG8_SB(0, 0), b2, voffA);
            PG8_BAR; PG8_WAIT_L(0); PG8_MMA(0, 1, At, B1); PG8_BAR;
            PG8_LDA(At, 0, 1); PG8_STAGE(PG8_SA(0, 0), a2, voffA);
            PG8_BAR; PG8_WAIT_L(0); PG8_MMA(1, 0, At, B0); PG8_BAR; PG8_SCHED;
            PG8_STAGE(PG8_SB(0, 1), b2 + hstep, voffA);
            PG8_WAIT_V(6); PG8_BAR; PG8_MMA(1, 1, At, B1); PG8_BAR;
            PG8_LDB(B0, 1, 0); PG8_SCHED; PG8_LDA(At, 1, 0); PG8_STAGE(PG8_SA(0, 1), a2 + hstep, voffA);
            PG8_WAIT_L(8); PG8_BAR; PG8_WAIT_L(0); PG8_MMA(0, 0, At, B0); PG8_BAR; PG8_SCHED;
            PG8_LDB(B1, 1, 1); PG8_STAGE(PG8_SB(1, 0), b3, voffA);
            PG8_BAR; PG8_WAIT_L(0); PG8_MMA(0, 1, At, B1); PG8_BAR;
            PG8_LDA(At, 1, 1); PG8_STAGE(PG8_SA(1, 0), a3, voffA);
            PG8_BAR; PG8_WAIT_L(0); PG8_MMA(1, 0, At, B0); PG8_BAR; PG8_SCHED;
            PG8_STAGE(PG8_SB(1, 1), b3 + hstep, voffA);
            PG8_WAIT_V(6); PG8_BAR; PG8_MMA(1, 1, At, B1); PG8_BAR;
        }
        bool keep = false;
        if constexpr (Epi::TWO_SEG) { if (cur.seg == 0) { E.mid(acc, cur, wr, wc, fr, fq); keep = true; } else E(acc, cur, wr, wc, fr, fq); }
        else E(acc, cur, wr, wc, fr, fq);
        if (!has_next) break;
        if (!keep)
#pragma unroll
        for (int a = 0; a < 2; ++a)
#pragma unroll
            for (int b = 0; b < 2; ++b)
#pragma unroll
                for (int m = 0; m < 4; ++m)
#pragma unroll
                    for (int n = 0; n < 2; ++n) acc[a][b][m][n] = (f32x4){0.f, 0.f, 0.f, 0.f};
        cur = nxt; cA = nA; cB = nB; ++ui;
    }
    PG8_WAIT_V(0);
    if (wr == 0) PG8_BAR;
    PG8_BAR;
#undef PG8_SA
#undef PG8_SB
#undef PG8_STAGE
#undef PG8_LDA
#undef PG8_LDB
#undef PG8_MMA
#undef PG8_WAIT_V
#undef PG8_WAIT_L
#undef PG8_BAR
#undef PG8_SCHED
}
}
using pg8::Unit;
typedef f32x4 AccT[2][2][4][2];

#define EPI_LOOP_BEGIN \
    _Pragma("unroll") for (int ai = 0; ai < 2; ++ai) _Pragma("unroll") for (int m = 0; m < 4; ++m) { const int row = u.pm * 256 + ai * 128 + wr * 64 + m * 16 + fr; \
    _Pragma("unroll") for (int bj = 0; bj < 2; ++bj) { const int cb = u.pn * 256 + bj * 128 + wc * 32; const f32x4 v0 = acc[ai][bj][m][0], v1 = acc[ai][bj][m][1];
#define EPI_LOOP_END } }

struct EpiF32 {
    static constexpr bool TWO_SEG = false;
    bf16_t* C; int ldc; bf16_t* C1;
    __device__ __forceinline__ void operator()(const AccT& acc, const Unit& u, int wr, int wc, int fr, int fq) const {
        bf16_t* Cb = u.ks ? C1 : C;
        EPI_LOOP_BEGIN
            bf16_t* p = Cb + (size_t)row * ldc + cb + 4 * fq;
            uint2 o0, o1; o0.x = cvt_pk_bf16(v0[0], v0[1]); o0.y = cvt_pk_bf16(v0[2], v0[3]); o1.x = cvt_pk_bf16(v1[0], v1[1]); o1.y = cvt_pk_bf16(v1[2], v1[3]);
            *(uint2*)p = o0; *(uint2*)(p + 16) = o1;
        EPI_LOOP_END
    }
};
struct EpiSwiglu {
    static constexpr bool TWO_SEG = false;
    bf16_t* O;
    __device__ __forceinline__ void operator()(const AccT& acc, const Unit& u, int wr, int wc, int fr, int fq) const {
        EPI_LOOP_BEGIN
            float r[4];
#pragma unroll
            for (int j = 0; j < 4; ++j) r[j] = siluf_(v0[j]) * v1[j];
            uint2 o; o.x = cvt_pk_bf16(r[0], r[1]); o.y = cvt_pk_bf16(r[2], r[3]);
            *(uint2*)(O + (size_t)row * DFF + (cb >> 1) + 4 * fq) = o;
        EPI_LOOP_END
    }
};
struct EpiProj {
    static constexpr bool TWO_SEG = false;
    bf16_t* proj; bf16_t* vgt; float* small;
    __device__ __forceinline__ void operator()(const AccT& acc, const Unit& u, int wr, int wc, int fr, int fq) const {
        EPI_LOOP_BEGIN
            if (cb >= 2048 && cb < 4096) {
                const unsigned pa = cvt_pk_bf16(v0[0], v0[1]), pb = cvt_pk_bf16(v0[2], v0[3]), pc = cvt_pk_bf16(v1[0], v1[1]), pd = cvt_pk_bf16(v1[2], v1[3]);
                bf16_t* vp = vgt + (size_t)(cb - 2048 + 4 * fq) * TT + row;
                vp[0] = (bf16_t)pa; vp[(size_t)TT] = (bf16_t)(pa >> 16); vp[(size_t)2 * TT] = (bf16_t)pb; vp[(size_t)3 * TT] = (bf16_t)(pb >> 16);
                vp[(size_t)16 * TT] = (bf16_t)pc; vp[(size_t)17 * TT] = (bf16_t)(pc >> 16); vp[(size_t)18 * TT] = (bf16_t)pd; vp[(size_t)19 * TT] = (bf16_t)(pd >> 16);
            } else if (cb >= 6144 && cb < 7264) {
                float* p = small + (size_t)row * SMALL_LD + (cb - 6144) + 4 * fq; *(f32x4*)p = v0; *(f32x4*)(p + 16) = v1;
            } else if (cb < 11360) {
                const int cc = cb < 2048 ? cb : (cb < 6144 ? cb - 2048 : cb - 7264 + 4096);
                bf16_t* p = proj + (size_t)row * PROJ_LD + cc + 4 * fq;
                uint2 o0, o1; o0.x = cvt_pk_bf16(v0[0], v0[1]); o0.y = cvt_pk_bf16(v0[2], v0[3]); o1.x = cvt_pk_bf16(v1[0], v1[1]); o1.y = cvt_pk_bf16(v1[2], v1[3]);
                *(uint2*)p = o0; *(uint2*)(p + 16) = o1;
            }
        EPI_LOOP_END
    }
};
struct EpiQ {
    static constexpr bool TWO_SEG = false;
    bf16_t* Q; const float* rope;
    __device__ __forceinline__ void operator()(const AccT& acc, const Unit& u, int wr, int wc, int fr, int fq) const {
        EPI_LOOP_BEGIN
            f32x4 a = v0, b = v1;
            const int w0 = cb % 192;
            if (w0 >= 128 && row >= NCTX) {
                const int it = (row - NCTX) & 2047;
                const int pos = (w0 == 128) ? (it >> 6) : (it & 63);
                const float* rp = rope + (pos * 16 + 4 * fq) * 2;
#pragma unroll
                for (int j = 0; j < 4; ++j) { const float cs = rp[2 * j], sn = rp[2 * j + 1]; a[j] = v0[j] * cs - v1[j] * sn; b[j] = v1[j] * cs + v0[j] * sn; }
            }
            bf16_t* p = Q + (size_t)row * 3072 + cb + 4 * fq;
            uint2 o0, o1; o0.x = cvt_pk_bf16(a[0], a[1]); o0.y = cvt_pk_bf16(a[2], a[3]); o1.x = cvt_pk_bf16(b[0], b[1]); o1.y = cvt_pk_bf16(b[2], b[3]);
            *(uint2*)p = o0; *(uint2*)(p + 16) = o1;
        EPI_LOOP_END
    }
};
struct EpiKV {
    static constexpr bool TWO_SEG = false;
    bf16_t* KN; bf16_t* VT;
    __device__ __forceinline__ void operator()(const AccT& acc, const Unit& u, int wr, int wc, int fr, int fq) const {
        EPI_LOOP_BEGIN
            const int head = cb >> 8, w0 = cb & 255;
            if (w0 < 128) {
                bf16_t* p = KN + (size_t)row * 2048 + head * 128 + w0 + 4 * fq;
                uint2 o0, o1; o0.x = cvt_pk_bf16(v0[0], v0[1]); o0.y = cvt_pk_bf16(v0[2], v0[3]); o1.x = cvt_pk_bf16(v1[0], v1[1]); o1.y = cvt_pk_bf16(v1[2], v1[3]);
                *(uint2*)p = o0; *(uint2*)(p + 16) = o1;
            } else {
                const int dv = head * 128 + (w0 - 128) + 4 * fq;
                const unsigned pa = cvt_pk_bf16(v0[0], v0[1]), pb = cvt_pk_bf16(v0[2], v0[3]), pc = cvt_pk_bf16(v1[0], v1[1]), pd = cvt_pk_bf16(v1[2], v1[3]);
                bf16_t* vp = VT + (size_t)dv * KVR + row;
                vp[0] = (bf16_t)pa; vp[(size_t)KVR] = (bf16_t)(pa >> 16); vp[(size_t)2 * KVR] = (bf16_t)pb; vp[(size_t)3 * KVR] = (bf16_t)(pb >> 16);
                vp[(size_t)16 * KVR] = (bf16_t)pc; vp[(size_t)17 * KVR] = (bf16_t)(pc >> 16); vp[(size_t)18 * KVR] = (bf16_t)pd; vp[(size_t)19 * KVR] = (bf16_t)(pd >> 16);
            }
        EPI_LOOP_END
    }
};
struct EpiGate {
    static constexpr bool TWO_SEG = true;
    const bf16_t* proj; bf16_t* Mo;
    __device__ __forceinline__ void mid(AccT& acc, const Unit& u, int wr, int wc, int fr, int fq) const {
#pragma unroll
        for (int ai = 0; ai < 2; ++ai) {
            uint2 ga[4][2][2], gb[4][2][2];
#pragma unroll
            for (int m = 0; m < 4; ++m)
#pragma unroll
                for (int bj = 0; bj < 2; ++bj) {
                    const int row = u.pm * 256 + ai * 128 + wr * 64 + m * 16 + fr, cb = u.pn * 256 + bj * 128 + wc * 32;
                    const bf16_t* gp = proj + (size_t)row * PROJ_LD + 4096 + cb + 4 * fq;
                    ga[m][bj][0] = *(const uint2*)gp; ga[m][bj][1] = *(const uint2*)(gp + 16); gb[m][bj][0] = *(const uint2*)(gp + 2048); gb[m][bj][1] = *(const uint2*)(gp + 2048 + 16);
                }
#pragma unroll
            for (int m = 0; m < 4; ++m)
#pragma unroll
                for (int bj = 0; bj < 2; ++bj)
#pragma unroll
                    for (int n = 0; n < 2; ++n) {
                        const uint2 a = ga[m][bj][n], bb = gb[m][bj][n];
                        f32x4 r;
                        r[0] = (1.f + __expf(-bflo(bb.x))) * __builtin_amdgcn_rcpf(1.f + __expf(-bflo(a.x))); r[1] = (1.f + __expf(-bfhi(bb.x))) * __builtin_amdgcn_rcpf(1.f + __expf(-bfhi(a.x)));
                        r[2] = (1.f + __expf(-bflo(bb.y))) * __builtin_amdgcn_rcpf(1.f + __expf(-bflo(a.y))); r[3] = (1.f + __expf(-bfhi(bb.y))) * __builtin_amdgcn_rcpf(1.f + __expf(-bfhi(a.y)));
                        acc[ai][bj][m][n] *= r;
                    }
        }
    }
    __device__ __forceinline__ void operator()(const AccT& acc, const Unit& u, int wr, int wc, int fr, int fq) const {
#pragma unroll
        for (int ai = 0; ai < 2; ++ai) {
            uint2 gb[4][2][2];
#pragma unroll
            for (int m = 0; m < 4; ++m)
#pragma unroll
                for (int bj = 0; bj < 2; ++bj) {
                    const int row = u.pm * 256 + ai * 128 + wr * 64 + m * 16 + fr, cb = u.pn * 256 + bj * 128 + wc * 32;
                    const bf16_t* gp = proj + (size_t)row * PROJ_LD + 6144 + cb + 4 * fq;
                    gb[m][bj][0] = *(const uint2*)gp; gb[m][bj][1] = *(const uint2*)(gp + 16);
                }
#pragma unroll
            for (int m = 0; m < 4; ++m)
#pragma unroll
                for (int bj = 0; bj < 2; ++bj) {
                    const int row = u.pm * 256 + ai * 128 + wr * 64 + m * 16 + fr, cb = u.pn * 256 + bj * 128 + wc * 32;
                    const f32x4 v0 = acc[ai][bj][m][0], v1 = acc[ai][bj][m][1];
                    const uint2 g0 = gb[m][bj][0], g1 = gb[m][bj][1];
                    f32x4 a, b;
                    a[0] = v0[0] * sigmoidf_(bflo(g0.x)); a[1] = v0[1] * sigmoidf_(bfhi(g0.x)); a[2] = v0[2] * sigmoidf_(bflo(g0.y)); a[3] = v0[3] * sigmoidf_(bfhi(g0.y));
                    b[0] = v1[0] * sigmoidf_(bflo(g1.x)); b[1] = v1[1] * sigmoidf_(bfhi(g1.x)); b[2] = v1[2] * sigmoidf_(bflo(g1.y)); b[3] = v1[3] * sigmoidf_(bfhi(g1.y));
                    bf16_t* p = Mo + (size_t)row * DM + cb + 4 * fq;
                    uint2 o0, o1; o0.x = cvt_pk_bf16(a[0], a[1]); o0.y = cvt_pk_bf16(a[2], a[3]); o1.x = cvt_pk_bf16(b[0], b[1]); o1.y = cvt_pk_bf16(b[2], b[3]);
                    *(uint2*)p = o0; *(uint2*)(p + 16) = o1;
                }
        }
    }
};

template <class Epi>
__device__ __forceinline__ void run_gemm(unsigned char* lds, const bf16_t* A, const bf16_t* Bt, int M, int N, int K, const Epi& E, int split = 1, const bf16_t* A1 = nullptr, const bf16_t* Bt1 = nullptr) {
    pg8::Gemm g{A, Bt, M, N, K, A1 ? A1 : A, Bt1 ? Bt1 : Bt};
    pg8::StaticOrder S; S.init(M, N, K, gridDim.x, blockIdx.x, split, A1 ? 2 : 1);
    pg8::gemm_phase<Epi>((LAS unsigned char*)lds, g, S, E);
    __syncthreads();
}

constexpr int CNT = 4;
__device__ __forceinline__ void conv_tile(float* tl, const float* __restrict__ src, int K, int N, bf16_t* dst, int mode, int nt, int kt) {
    const int tid = threadIdx.x;
    const int nl = tid & 63, k8 = tid >> 6;
    float v[CNT][8];
#pragma unroll
    for (int s2 = 0; s2 < CNT; ++s2) {
        const int np = (nt * CNT + s2) * 64 + nl;
        int j = np;
        if (mode == 1) { const int blk = np >> 5, r = np & 31; j = blk * 16 + (r & 15) + ((r >> 4) ? DFF : 0); }
        const bool valid = j < N;
#pragma unroll
        for (int i = 0; i < 8; ++i) {
            const int k = kt * 64 + k8 + 8 * i;
            v[s2][i] = valid ? __builtin_nontemporal_load(&src[(size_t)k * N + j]) : 0.f;
        }
    }
#pragma unroll
    for (int s2 = 0; s2 < CNT; ++s2)
#pragma unroll
        for (int i = 0; i < 8; ++i) tl[s2 * 64 * 65 + (k8 + 8 * i) * 65 + nl] = v[s2][i];
    __syncthreads();
    const int n2 = tid >> 3, kc = (tid & 7) * 8;
#pragma unroll
    for (int s2 = 0; s2 < CNT; ++s2) {
        const float* t2 = tl + s2 * 64 * 65;
        uint4 o;
        o.x = cvt_pk_bf16(t2[(kc + 0) * 65 + n2], t2[(kc + 1) * 65 + n2]);
        o.y = cvt_pk_bf16(t2[(kc + 2) * 65 + n2], t2[(kc + 3) * 65 + n2]);
        o.z = cvt_pk_bf16(t2[(kc + 4) * 65 + n2], t2[(kc + 5) * 65 + n2]);
        o.w = cvt_pk_bf16(t2[(kc + 6) * 65 + n2], t2[(kc + 7) * 65 + n2]);
        *(uint4*)(dst + (size_t)((nt * CNT + s2) * 64 + n2) * K + kt * 64 + kc) = o;
    }
    __syncthreads();
}
__device__ __forceinline__ void conv_job(float* tl, int& base, const float* src, int K, int N, bf16_t* dst, int nrows, int mode, int bidx = -1, int nblk = 0) {
    if (bidx < 0) { bidx = blockIdx.x; nblk = gridDim.x; }
    const int kts = K / 64, ntile = (nrows / (64 * CNT)) * kts;
    int first = bidx - (base % nblk); if (first < 0) first += nblk;
    for (int t = first; t < ntile; t += nblk) conv_tile(tl, src, K, N, dst, mode, t / kts, t % kts);
    base += ntile;
}

__device__ __forceinline__ void ada_item(const Params& p, float* lds, int item) {
    const int tid = threadIdx.x, w = tid >> 6, lane = tid & 63;
    const int nc = item % 72, ks = item / 72;
    float* sc = lds;
    float* red = lds + 5 * 512;
    for (int i = tid; i < 5 * 512; i += 512) {
        const int r = i / 512, k = ks * 512 + (i % 512);
        const float v = r == 0 ? p.c_ctx[k] : p.c[(r - 1) * DM + k];
        sc[i] = siluf_(v);
    }
    __syncthreads();
    float acc[5][4];
#pragma unroll
    for (int r = 0; r < 5; ++r)
#pragma unroll
        for (int j = 0; j < 4; ++j) acc[r][j] = 0.f;
    const float* wp = p.w_ada + (size_t)(ks * 512 + w * 64) * 18432 + nc * 256 + lane * 4;
#pragma unroll 8
    for (int kk = 0; kk < 64; ++kk) {
        const f32x4 wv = __builtin_nontemporal_load((const f32x4*)(wp + (size_t)kk * 18432));
#pragma unroll
        for (int r = 0; r < 5; ++r) {
            const float s = sc[r * 512 + w * 64 + kk];
#pragma unroll
            for (int j = 0; j < 4; ++j) acc[r][j] += s * wv[j];
        }
    }
#pragma unroll
    for (int r = 0; r < 5; ++r) *(f32x4*)(red + (w * 5 + r) * 256 + lane * 4) = (f32x4){acc[r][0], acc[r][1], acc[r][2], acc[r][3]};
    __syncthreads();
    float* modp = (float*)(p.ws + WS_MODP);
    for (int i = tid; i < 5 * 256; i += 512) {
        const int r = i / 256, cidx = i % 256;
        float s = 0.f;
#pragma unroll
        for (int ww = 0; ww < 8; ++ww) s += red[(ww * 5 + r) * 256 + cidx];
        modp[(size_t)(ks * 5 + r) * 18432 + nc * 256 + cidx] = s;
    }
    __syncthreads();
}

__device__ __forceinline__ void row_phase(const Params& p, int mode) {
    const int w = threadIdx.x >> 6, lane = threadIdx.x & 63;
    const float* mod = (const float*)(p.ws + WS_MOD);
    float* XR = p.out + OUT_Y;
    const bf16_t* Y = (const bf16_t*)(p.ws + WS_R2);
    const bf16_t* Y1 = (const bf16_t*)(p.ws + WS_Y1);
    bf16_t* H = (bf16_t*)(p.ws + WS_H);
    for (int row = blockIdx.x * 8 + w; row < TT; row += gridDim.x * 8) {
        const int mr = row < NCTX ? 0 : 1 + ((row - NCTX) >> 11);
        const float* mrow = mod + (size_t)mr * 18432;
        const float* xin = (mode <= 2) ? (row < NCTX ? p.x_prompt + (size_t)row * DM : p.x_sample + (size_t)(row - NCTX) * DM) : XR + (size_t)row * DM;
        f32x4 xv[8];
#pragma unroll
        for (int i = 0; i < 8; ++i) xv[i] = __builtin_nontemporal_load((const f32x4*)(xin + lane * 4 + 256 * i));
        if (mode >= 2) {
            const int gi = mode == 2 ? 2 : (mode == 3 ? 5 : 8), ni = mode == 2 ? 1 : (mode == 3 ? 3 : 5);
            const float coef = mode == 3 ? 1.f : 0.5f;
            f32x4 yv[8]; float ss = 0.f;
#pragma unroll
            for (int i = 0; i < 8; ++i) { const u32x2 ya = __builtin_nontemporal_load((const u32x2*)(Y + (size_t)row * DM + lane * 4 + 256 * i)), yb = __builtin_nontemporal_load((const u32x2*)(Y1 + (size_t)row * DM + lane * 4 + 256 * i));
                yv[i] = (f32x4){bflo(ya.x) + bflo(yb.x), bfhi(ya.x) + bfhi(yb.x), bflo(ya.y) + bflo(yb.y), bfhi(ya.y) + bfhi(yb.y)}; ss += yv[i][0] * yv[i][0] + yv[i][1] * yv[i][1] + yv[i][2] * yv[i][2] + yv[i][3] * yv[i][3]; }
            ss = wave_sum(ss);
            const float r = rsqrtf(ss * (1.f / DM) + 1e-6f);
#pragma unroll
            for (int i = 0; i < 8; ++i) {
                const f32x4 gt = *(const f32x4*)(mrow + gi * DM + lane * 4 + 256 * i);
                const f32x4 gn = *(const f32x4*)(p.norm_gains + ni * DM + lane * 4 + 256 * i);
#pragma unroll
                for (int j = 0; j < 4; ++j) xv[i][j] += coef * gt[j] * (yv[i][j] * r * gn[j]);
                if (mode == 4) __builtin_nontemporal_store(xv[i], (f32x4*)(XR + (size_t)row * DM + lane * 4 + 256 * i)); else *(f32x4*)(XR + (size_t)row * DM + lane * 4 + 256 * i) = xv[i];
            }
        }
        if (mode <= 3) {
            const int ni = mode == 1 ? 0 : (mode == 2 ? 2 : 4), shi = mode == 1 ? 0 : (mode == 2 ? 3 : 6);
            float ss = 0.f;
#pragma unroll
            for (int i = 0; i < 8; ++i) ss += xv[i][0] * xv[i][0] + xv[i][1] * xv[i][1] + xv[i][2] * xv[i][2] + xv[i][3] * xv[i][3];
            ss = wave_sum(ss);
            const float r = rsqrtf(ss * (1.f / DM) + 1e-6f);
#pragma unroll
            for (int i = 0; i < 8; ++i) {
                const f32x4 sh = *(const f32x4*)(mrow + shi * DM + lane * 4 + 256 * i);
                const f32x4 sc = *(const f32x4*)(mrow + (shi + 1) * DM + lane * 4 + 256 * i);
                const f32x4 gn = *(const f32x4*)(p.norm_gains + ni * DM + lane * 4 + 256 * i);
                float h[4];
#pragma unroll
                for (int j = 0; j < 4; ++j) h[j] = xv[i][j] * r * gn[j] * (1.f + sc[j]) + sh[j];
                uint2 o; o.x = cvt_pk_bf16(h[0], h[1]); o.y = cvt_pk_bf16(h[2], h[3]);
                *(uint2*)(H + (size_t)row * DM + lane * 4 + 256 * i) = o;
            }
        }
    }
}

__device__ __forceinline__ void token_phase(const Params& p) {
    const int w = threadIdx.x >> 6, lane = threadIdx.x & 63;
    const float* small = (const float*)(p.ws + WS_SMALL);
    const float* rope = (const float*)(p.ws + WS_ROPE);
    bf16_t* CQN = (bf16_t*)(p.ws + WS_CQN);
    bf16_t* CKVA = (bf16_t*)(p.ws + WS_CKVA);
    bf16_t* KRA = (bf16_t*)(p.ws + WS_KRA);
    for (int kr = blockIdx.x * 8 + w; kr < KVR; kr += gridDim.x * 8) {
        int tok = -1, bidx = 0, pp = 0;
        if (kr < NCTX) tok = kr;
        else { bidx = (kr - NCTX) / 2304; pp = (kr - NCTX) % 2304; if (pp >= 256) tok = NCTX + bidx * 2048 + (pp - 256); }
        if (tok < 0) {
            const float* s = p.cache_ckv + ((size_t)bidx * 256 + pp) * 512 + lane * 8;
            const f32x4 a = *(const f32x4*)s, b = *(const f32x4*)(s + 4);
            uint4 o; o.x = cvt_pk_bf16(a[0], a[1]); o.y = cvt_pk_bf16(a[2], a[3]); o.z = cvt_pk_bf16(b[0], b[1]); o.w = cvt_pk_bf16(b[2], b[3]);
            *(uint4*)(CKVA + (size_t)kr * 512 + lane * 8) = o;
            KRA[(size_t)kr * 64 + lane] = f2bf(p.cache_krope[((size_t)bidx * 256 + pp) * 64 + lane]);
            continue;
        }
        const float* srow = small + (size_t)tok * SMALL_LD;
        if (lane < 32) ((float*)(p.ws + WS_ACMP))[(size_t)tok * 32 + lane] = srow[lane];
        {
            const f32x4 a = __builtin_nontemporal_load((const f32x4*)(srow + 32 + lane * 8)), b = __builtin_nontemporal_load((const f32x4*)(srow + 36 + lane * 8));
            float ss = a[0] * a[0] + a[1] * a[1] + a[2] * a[2] + a[3] * a[3] + b[0] * b[0] + b[1] * b[1] + b[2] * b[2] + b[3] * b[3];
            ss = wave_sum(ss);
            const float r = rsqrtf(ss * (1.f / 512.f) + 1e-6f);
            const f32x4 g0 = *(const f32x4*)(p.q_norm + lane * 8), g1 = *(const f32x4*)(p.q_norm + lane * 8 + 4);
            uint4 o; o.x = cvt_pk_bf16(a[0] * r * g0[0], a[1] * r * g0[1]); o.y = cvt_pk_bf16(a[2] * r * g0[2], a[3] * r * g0[3]);
            o.z = cvt_pk_bf16(b[0] * r * g1[0], b[1] * r * g1[1]); o.w = cvt_pk_bf16(b[2] * r * g1[2], b[3] * r * g1[3]);
            *(uint4*)(CQN + (size_t)tok * 512 + lane * 8) = o;
        }
        {
            const f32x4 a = __builtin_nontemporal_load((const f32x4*)(srow + 544 + lane * 8)), b = __builtin_nontemporal_load((const f32x4*)(srow + 548 + lane * 8));
            float ss = a[0] * a[0] + a[1] * a[1] + a[2] * a[2] + a[3] * a[3] + b[0] * b[0] + b[1] * b[1] + b[2] * b[2] + b[3] * b[3];
            ss = wave_sum(ss);
            const float r = rsqrtf(ss * (1.f / 512.f) + 1e-6f);
            const f32x4 g0 = *(const f32x4*)(p.kv_norm + lane * 8), g1 = *(const f32x4*)(p.kv_norm + lane * 8 + 4);
            f32x4 ya, yb;
#pragma unroll
            for (int j = 0; j < 4; ++j) { ya[j] = a[j] * r * g0[j]; yb[j] = b[j] * r * g1[j]; }
            uint4 o; o.x = cvt_pk_bf16(ya[0], ya[1]); o.y = cvt_pk_bf16(ya[2], ya[3]); o.z = cvt_pk_bf16(yb[0], yb[1]); o.w = cvt_pk_bf16(yb[2], yb[3]);
            *(uint4*)(CKVA + (size_t)kr * 512 + lane * 8) = o;
            if (tok < NCTX) { float* op = p.out + OUT_CKV + (size_t)tok * 512 + lane * 8; *(f32x4*)op = ya; *(f32x4*)(op + 4) = yb; }
        }
        {
            const float v = srow[1056 + lane];
            if (tok < NCTX) { p.out[OUT_KROPE + (size_t)tok * 64 + lane] = v; KRA[(size_t)kr * 64 + lane] = f2bf(v); }
            else {
                const float pv = __shfl_xor(v, 16);
                const int it = (tok - NCTX) & 2047, axis = lane >> 5, half = (lane >> 4) & 1, fi = lane & 15;
                const int pos = axis == 0 ? (it >> 6) : (it & 63);
                const float cs = rope[(pos * 16 + fi) * 2], sn = rope[(pos * 16 + fi) * 2 + 1];
                const float o = half == 0 ? v * cs - pv * sn : v * cs + pv * sn;
                KRA[(size_t)kr * 64 + lane] = f2bf(o);
            }
        }
    }
}

__device__ __forceinline__ void gla_post_phase(const Params& p) {
    const int w = threadIdx.x >> 6, lane = threadIdx.x & 63;
    const bf16_t* OF = (const bf16_t*)(p.ws + WS_R2);
    const bf16_t* OB = OF + (size_t)TT * DM;
    const bf16_t* proj = (const bf16_t*)(p.ws + WS_R1);
    bf16_t* OG = (bf16_t*)(p.ws + WS_Q);
    const f32x4 gn0 = *(const f32x4*)(p.gla_norm + lane * 8), gn1 = *(const f32x4*)(p.gla_norm + lane * 8 + 4);
    for (int row = blockIdx.x * 8 + w; row < TT; row += gridDim.x * 8) {
#pragma unroll
        for (int h = 0; h < 4; ++h) {
            const size_t off = (size_t)row * DM + h * 512 + lane * 8;
            const u32x4 a = __builtin_nontemporal_load((const u32x4*)(OF + off)), b = __builtin_nontemporal_load((const u32x4*)(OB + off));
            const u32x4 rg = __builtin_nontemporal_load((const u32x4*)(proj + (size_t)row * PROJ_LD + 2048 + h * 512 + lane * 8));
            float o[8], g[8];
            o[0] = bflo(a.x) + bflo(b.x); o[1] = bfhi(a.x) + bfhi(b.x); o[2] = bflo(a.y) + bflo(b.y); o[3] = bfhi(a.y) + bfhi(b.y);
            o[4] = bflo(a.z) + bflo(b.z); o[5] = bfhi(a.z) + bfhi(b.z); o[6] = bflo(a.w) + bflo(b.w); o[7] = bfhi(a.w) + bfhi(b.w);
            g[0] = bflo(rg.x); g[1] = bfhi(rg.x); g[2] = bflo(rg.y); g[3] = bfhi(rg.y); g[4] = bflo(rg.z); g[5] = bfhi(rg.z); g[6] = bflo(rg.w); g[7] = bfhi(rg.w);
            float ss = 0.f;
#pragma unroll
            for (int j = 0; j < 8; ++j) ss += o[j] * o[j];
            ss = wave_sum(ss);
            const float r = rsqrtf(ss * (1.f / 512.f) + 1e-6f);
            float y[8];
#pragma unroll
            for (int j = 0; j < 8; ++j) y[j] = o[j] * r * (j < 4 ? gn0[j] : gn1[j - 4]) * siluf_(g[j]);
            uint4 ov; ov.x = cvt_pk_bf16(y[0], y[1]); ov.y = cvt_pk_bf16(y[2], y[3]); ov.z = cvt_pk_bf16(y[4], y[5]); ov.w = cvt_pk_bf16(y[6], y[7]);
            *(uint4*)(OG + off) = ov;
        }
    }
}

__device__ __forceinline__ void attn_item(const Params& p, unsigned char* ldsb, int s, int h, int qb) {
    int tid = threadIdx.x; asm volatile("" : "+v"(tid));
    const int w = tid >> 6, lane = tid & 63, lr = lane & 15, g = lane >> 4;
    int tok0, kr0, nkv;
    if (s < 16) { tok0 = s * 256; kr0 = s * 256; nkv = 256; } else { const int b = s - 16; tok0 = NCTX + b * 2048 + qb * 256; kr0 = NCTX + b * 2304; nkv = 2304; }
    const bf16_t* Q = (const bf16_t*)(p.ws + WS_Q);
    const bf16_t* KN = (const bf16_t*)(p.ws + WS_KN);
    const bf16_t* VT = (const bf16_t*)(p.ws + WS_VT);
    const bf16_t* KR = (const bf16_t*)(p.ws + WS_KRA);
    bf16_t* OM = (bf16_t*)(p.ws + WS_OM);
    bf16_t* lds = (bf16_t*)ldsb;
    constexpr int KST = 200, VST = 72, STAGE = 64 * KST + 128 * VST;
    bf16x8 Bq[2][6];
#pragma unroll
    for (int qf = 0; qf < 2; ++qf)
#pragma unroll
        for (int ks = 0; ks < 6; ++ks) Bq[qf][ks] = *(const bf16x8*)(Q + (size_t)(tok0 + 32 * w + 16 * qf + lr) * 3072 + h * 192 + 32 * ks + 8 * g);
    f32x4 O[8][2];
#pragma unroll
    for (int df = 0; df < 8; ++df) { O[df][0] = (f32x4){0.f, 0.f, 0.f, 0.f}; O[df][1] = (f32x4){0.f, 0.f, 0.f, 0.f}; }
    float mrun[2] = {-1e30f, -1e30f}, lrun[2] = {0.f, 0.f}, mpend[2] = {-1e30f, -1e30f};
    const float cscale = 0.07216878364870322f * 1.4426950408889634f;
    uint4 rk0, rk1, rk2, rv0, rv1;
    const int nt = nkv / 64;
#define ATT_LK(i, dst, t) do { const int id = tid + 512 * (i), row = id / 24, c = id % 24; const size_t krw = (size_t)(kr0 + 64 * (t) + row); \
        const bf16_t* src = c < 16 ? KN + krw * 2048 + h * 128 + 8 * c : KR + krw * 64 + 8 * (c - 16); dst = *(const uint4*)src; } while (0)
#define ATT_LV(i, dst, t) do { const int id = tid + 512 * (i), dv = id >> 3, c = id & 7; dst = *(const uint4*)(VT + (size_t)(h * 128 + dv) * KVR + kr0 + 64 * (t) + 8 * c); } while (0)
#define ATT_LOAD(t) do { ATT_LK(0, rk0, t); ATT_LK(1, rk1, t); ATT_LK(2, rk2, t); ATT_LV(0, rv0, t); ATT_LV(1, rv1, t); } while (0)
#define ATT_SK(i, src_, Kb_) do { const int id = tid + 512 * (i), row = id / 24, c = id % 24; *(uint4*)((Kb_) + row * KST + 8 * c) = src_; } while (0)
#define ATT_SV(i, src_, Vb_) do { const int id = tid + 512 * (i), dv = id >> 3, c = id & 7; *(uint4*)((Vb_) + dv * VST + 8 * c) = src_; } while (0)
#define ATT_STORE(buf) do { bf16_t* Kb_ = lds + (buf) * STAGE; bf16_t* Vb_ = Kb_ + 64 * KST; ATT_SK(0, rk0, Kb_); ATT_SK(1, rk1, Kb_); ATT_SK(2, rk2, Kb_); ATT_SV(0, rv0, Vb_); ATT_SV(1, rv1, Vb_); } while (0)
    ATT_LOAD(0); ATT_STORE(0);
    __syncthreads();
    for (int t = 0; t < nt; ++t) {
        const bf16_t* Kb = lds + (t & 1) * STAGE; const bf16_t* Vb = Kb + 64 * KST;
        bf16_t* Kn = lds + ((t + 1) & 1) * STAGE; bf16_t* Vn = Kn + 64 * KST;
        const bool more = (t + 1 < nt);
        if (more) { ATT_LK(0, rk0, t + 1); ATT_LK(1, rk1, t + 1); ATT_LK(2, rk2, t + 1); }
        f32x4 st[4][2];
#pragma unroll
        for (int kf = 0; kf < 4; ++kf) { st[kf][0] = (f32x4){0.f, 0.f, 0.f, 0.f}; st[kf][1] = (f32x4){0.f, 0.f, 0.f, 0.f}; }
#pragma unroll
        for (int ks = 0; ks < 6; ++ks)
#pragma unroll
            for (int kf = 0; kf < 4; ++kf) {
                const bf16x8 a = *(const bf16x8*)(Kb + (16 * kf + lr) * KST + 32 * ks + 8 * g);
                st[kf][0] = __builtin_amdgcn_mfma_f32_16x16x32_bf16(a, Bq[0][ks], st[kf][0], 0, 0, 0);
                st[kf][1] = __builtin_amdgcn_mfma_f32_16x16x32_bf16(a, Bq[1][ks], st[kf][1], 0, 0, 0);
                if (kf & 1) __builtin_amdgcn_sched_barrier(0);
            }
        if (more) { ATT_SK(0, rk0, Kn); ATT_SK(1, rk1, Kn); ATT_SK(2, rk2, Kn); ATT_LV(0, rv0, t + 1); ATT_LV(1, rv1, t + 1); }
        bf16x8 Bp[2][2];
#pragma unroll
        for (int qf = 0; qf < 2; ++qf) {
            float mx = st[0][qf][0];
#pragma unroll
            for (int kf = 0; kf < 4; ++kf)
#pragma unroll
                for (int r = 0; r < 4; ++r) mx = fmaxf(mx, st[kf][qf][r]);
            mx = fmaxf(mx, __shfl_xor(mx, 16)); mx = fmaxf(mx, __shfl_xor(mx, 32));
            const float mnew = (t == 0) ? mx * cscale : fmaxf(mrun[qf], mpend[qf]);
            mpend[qf] = mx * cscale;
            const float alpha = __builtin_amdgcn_exp2f(mrun[qf] - mnew);
            mrun[qf] = mnew;
            float ps = 0.f; float pv[4][4];
#pragma unroll
            for (int kf = 0; kf < 4; ++kf)
#pragma unroll
                for (int r = 0; r < 4; ++r) { pv[kf][r] = __builtin_amdgcn_exp2f(st[kf][qf][r] * cscale - mnew); ps += pv[kf][r]; }
            lrun[qf] = lrun[qf] * alpha + ps;
#pragma unroll
            for (int df = 0; df < 8; ++df) O[df][qf] *= alpha;
#pragma unroll
            for (int s2 = 0; s2 < 2; ++s2) {
                union { bf16x8 v; unsigned u[4]; } pk;
                pk.u[0] = cvt_pk_bf16(pv[2 * s2][0], pv[2 * s2][1]); pk.u[1] = cvt_pk_bf16(pv[2 * s2][2], pv[2 * s2][3]);
                pk.u[2] = cvt_pk_bf16(pv[2 * s2 + 1][0], pv[2 * s2 + 1][1]); pk.u[3] = cvt_pk_bf16(pv[2 * s2 + 1][2], pv[2 * s2 + 1][3]);
                Bp[qf][s2] = pk.v;
            }
        }
#pragma unroll
        for (int s2 = 0; s2 < 2; ++s2)
#pragma unroll
            for (int df = 0; df < 8; ++df) {
                union { bf16x8 v; bf16x4 hh[2]; } a;
                a.hh[0] = *(const bf16x4*)(Vb + (16 * df + lr) * VST + 32 * s2 + 4 * g);
                a.hh[1] = *(const bf16x4*)(Vb + (16 * df + lr) * VST + 32 * s2 + 16 + 4 * g);
                O[df][0] = __builtin_amdgcn_mfma_f32_16x16x32_bf16(a.v, Bp[0][s2], O[df][0], 0, 0, 0);
                O[df][1] = __builtin_amdgcn_mfma_f32_16x16x32_bf16(a.v, Bp[1][s2], O[df][1], 0, 0, 0);
                if (df & 1) __builtin_amdgcn_sched_barrier(0);
            }
        if (more) { ATT_SV(0, rv0, Vn); ATT_SV(1, rv1, Vn); }
        __syncthreads();
    }
#undef ATT_LOAD
#undef ATT_STORE
#undef ATT_LK
#undef ATT_LV
#undef ATT_SK
#undef ATT_SV
    int tid2 = threadIdx.x; asm volatile("" : "+v"(tid2));
    const int w2 = tid2 >> 6, lr2 = tid2 & 15, g2 = (tid2 & 63) >> 4;
#pragma unroll
    for (int qf = 0; qf < 2; ++qf) {
        float l = lrun[qf]; l += __shfl_xor(l, 16); l += __shfl_xor(l, 32);
        const float inv = 1.f / l;
        bf16_t* op = OM + (size_t)(tok0 + 32 * w2 + 16 * qf + lr2) * DM + h * 128 + 4 * g2;
#pragma unroll
        for (int df = 0; df < 8; ++df) {
            uint2 o; o.x = cvt_pk_bf16(O[df][qf][0] * inv, O[df][qf][1] * inv); o.y = cvt_pk_bf16(O[df][qf][2] * inv, O[df][qf][3] * inv);
            *(uint2*)(op + 16 * df) = o;
        }
    }
}

__device__ __forceinline__ void gla_a_item(const Params& p, unsigned char* ldsb, int cg, int h, int dir) {
    int tid = threadIdx.x; asm volatile("" : "+v"(tid));
    const int w = tid >> 6, lane = tid & 63, lr = lane & 15, g = lane >> 4;
    const int c0 = cg * 64;
    const int it = (dir * 192 + cg) * 4 + h;
    const bf16_t* proj = (const bf16_t*)(p.ws + WS_R1);
    const bf16_t* VGT = (const bf16_t*)(p.ws + WS_VGT);
    const float* acmp = (const float*)(p.ws + WS_ACMP);
    bf16_t* OD = (bf16_t*)(p.ws + WS_R2) + (size_t)dir * TT * DM;
    bf16_t* QDg = (bf16_t*)(p.ws + WS_QD) + (size_t)it * 64 * 256;
    bf16_t* KITg = (bf16_t*)(p.ws + WS_KIT) + (size_t)it * 64 * 256;
    float* DECg = (float*)(p.ws + WS_DEC) + (size_t)it * 256;
    constexpr int QST = 264, TST = 72;
    bf16_t* qd = (bf16_t*)ldsb;
    bf16_t* kk = qd + 64 * QST;
    bf16_t* kinvT = kk + 64 * QST;
    bf16_t* vT = kinvT + 256 * TST;
    bf16_t* Amat = vT + 128 * TST;
    bf16_t* aop = Amat + 64 * TST;
    float* decay = (float*)(aop + 64 * TST);
    {
        uint4 rq0, rq1, rq2, rq3, rk0, rk1, rk2, rk3; f32x4 ra = (f32x4){0.f, 0.f, 0.f, 0.f};
#define GA_LQK(i, dq, dk) do { const int id = tid + 512 * (i), ir = id >> 5, c = id & 31; const size_t tok = (size_t)(c0 + (dir ? 63 - ir : ir)); \
        dq = *(const uint4*)(proj + tok * PROJ_LD + h * 256 + 8 * c); dk = *(const uint4*)(proj + tok * PROJ_LD + 1024 + h * 256 + 8 * c); } while (0)
#define GA_SQK(i, sq, sk) do { const int id = tid + 512 * (i), ir = id >> 5, c = id & 31; *(uint4*)(qd + ir * QST + 8 * c) = sq; *(uint4*)(kk + ir * QST + 8 * c) = sk; } while (0)
        GA_LQK(0, rq0, rk0); GA_LQK(1, rq1, rk1); GA_LQK(2, rq2, rk2); GA_LQK(3, rq3, rk3);
        if (tid < 256) { const int ir = tid >> 2, r4 = tid & 3; ra = *(const f32x4*)(acmp + (size_t)(c0 + (dir ? 63 - ir : ir)) * 32 + dir * 16 + 4 * r4); }
        GA_SQK(0, rq0, rk0); GA_SQK(1, rq1, rk1); GA_SQK(2, rq2, rk2); GA_SQK(3, rq3, rk3);
#undef GA_LQK
#undef GA_SQK
        if (tid < 256) {
            const int ir = tid >> 2, r4 = tid & 3;
            uint2 hv, lv;
            hv.x = cvt_pk_bf16(ra[0], ra[1]); hv.y = cvt_pk_bf16(ra[2], ra[3]);
            lv.x = cvt_pk_bf16(ra[0] - bflo(hv.x), ra[1] - bfhi(hv.x)); lv.y = cvt_pk_bf16(ra[2] - bflo(hv.y), ra[3] - bfhi(hv.y));
            bf16_t* ap = aop + ir * TST + 4 * r4;
            *(uint2*)ap = hv; *(uint2*)(ap + 16) = lv; *(uint2*)(ap + 32) = hv; *(uint2*)(ap + 48) = (uint2){0u, 0u};
        }
    }
    __syncthreads();
#pragma unroll
    for (int kfi = 0; kfi < 2; ++kfi) {
        const int k = 16 * (2 * w + kfi) + lr;
        bf16x8 Wb0, Wb1;
        {
            union { bf16x8 v; unsigned u[4]; } hi, lo;
#pragma unroll
            for (int j2 = 0; j2 < 4; ++j2) {
                const float w0 = p.w_gla_alpha[((size_t)dir * 16 + ((8 * g + 2 * j2) & 15)) * 1024 + h * 256 + k];
                const float w1 = p.w_gla_alpha[((size_t)dir * 16 + ((8 * g + 2 * j2 + 1) & 15)) * 1024 + h * 256 + k];
                const unsigned hu = cvt_pk_bf16(w0, w1);
                hi.u[j2] = hu;
                lo.u[j2] = (g < 2) ? cvt_pk_bf16(w0 - bflo(hu), w1 - bfhi(hu)) : 0u;
            }
            Wb0 = hi.v; Wb1 = lo.v;
        }
        const float bias = p.b_gla_alpha[(size_t)dir * 1024 + h * 256 + k];
        f32x4 la[4];
#pragma unroll
        for (int tf = 0; tf < 4; ++tf) {
            f32x4 a = (f32x4){0.f, 0.f, 0.f, 0.f};
            a = __builtin_amdgcn_mfma_f32_16x16x32_bf16(*(const bf16x8*)(aop + (16 * tf + lr) * TST + 8 * g), Wb0, a, 0, 0, 0);
            a = __builtin_amdgcn_mfma_f32_16x16x32_bf16(*(const bf16x8*)(aop + (16 * tf + lr) * TST + 32 + 8 * g), Wb1, a, 0, 0, 0);
#pragma unroll
            for (int r = 0; r < 4; ++r) { const float x = a[r] + bias; la[tf][r] = (fminf(x, 0.f) - __logf(1.f + __expf(-fabsf(x)))) * (1.f / 16.f); }
        }
        float run = 0.f;
#pragma unroll
        for (int tf = 0; tf < 4; ++tf) {
            la[tf][1] += la[tf][0]; la[tf][2] += la[tf][1]; la[tf][3] += la[tf][2];
            const float tot = la[tf][3];
            const float t0 = __shfl(tot, lr), t1 = __shfl(tot, lr + 16), t2 = __shfl(tot, lr + 32), t3 = __shfl(tot, lr + 48);
            const float off = run + (g > 0 ? t0 : 0.f) + (g > 1 ? t1 : 0.f) + (g > 2 ? t2 : 0.f);
#pragma unroll
            for (int r = 0; r < 4; ++r) la[tf][r] += off;
            run += t0 + t1 + t2 + t3;
        }
        if (g == 3) { const float d = __expf(la[3][3]); decay[k] = d; DECg[k] = d; }
#pragma unroll
        for (int tf = 0; tf < 4; ++tf) {
            float ki[4];
#pragma unroll
            for (int r = 0; r < 4; ++r) {
                const int i = 16 * tf + 4 * g + r;
                const float b = la[tf][r];
                const float qv = bf2f(qd[i * QST + k]) * __expf(b) * (1.f / 16.f);
                ki[r] = bf2f(kk[i * QST + k]) * __expf(-b);
                qd[i * QST + k] = f2bf(qv);
                kk[i * QST + k] = f2bf(ki[r]);
            }
            uint2 o; o.x = cvt_pk_bf16(ki[0], ki[1]); o.y = cvt_pk_bf16(ki[2], ki[3]);
            *(uint2*)(kinvT + k * TST + 16 * tf + 4 * g) = o;
        }
    }
    __syncthreads();
#pragma unroll
    for (int ff = 0; ff < 2; ++ff) {
        const int f = 2 * w + ff, jf = f >> 2, iff = f & 3;
        f32x4 a = (f32x4){0.f, 0.f, 0.f, 0.f};
        if (jf <= iff) {
#pragma unroll
            for (int ks = 0; ks < 8; ++ks)
                a = __builtin_amdgcn_mfma_f32_16x16x32_bf16(*(const bf16x8*)(kk + (16 * jf + lr) * QST + 32 * ks + 8 * g), *(const bf16x8*)(qd + (16 * iff + lr) * QST + 32 * ks + 8 * g), a, 0, 0, 0);
            if (jf == iff) {
#pragma unroll
                for (int r = 0; r < 4; ++r) if (4 * g + r > lr) a[r] = 0.f;
            }
        }
        uint2 o; o.x = cvt_pk_bf16(a[0], a[1]); o.y = cvt_pk_bf16(a[2], a[3]);
        *(uint2*)(Amat + (16 * iff + lr) * TST + 16 * jf + 4 * g) = o;
    }
#pragma unroll
    for (int i = 0; i < 4; ++i) {
        const int id = tid + 512 * i;
        { const int ir = id >> 5, c = id & 31; *(uint4*)(QDg + (size_t)ir * 256 + 8 * c) = *(const uint4*)(qd + ir * QST + 8 * c); }
        { const int k = id >> 3, c = id & 7; *(uint4*)(KITg + (size_t)k * 64 + 8 * c) = *(const uint4*)(kinvT + k * TST + 8 * c); }
    }
    __syncthreads();
    {
        bf16_t* AMg = (bf16_t*)(p.ws + WS_AM) + (size_t)it * 4096;
        const int i = tid >> 3, c = tid & 7;
        *(uint4*)(AMg + i * 64 + 8 * c) = *(const uint4*)(Amat + i * TST + 8 * c);
    }
}

__device__ __forceinline__ void gla_b_unit(const Params& p, unsigned char* ldsb, int s, int h, int dir, int vs) {
    int tid0 = threadIdx.x; asm volatile("" : "+v"(tid0));
    const int w = tid0 >> 6, lane = tid0 & 63, lr = lane & 15, g = lane >> 4;
    const int nch = s < 16 ? 4 : 32;
    const int tb = s < 16 ? s * 256 : NCTX + (s - 16) * 2048;
    const bf16_t* VGT = (const bf16_t*)(p.ws + WS_VGT);
    const bf16_t* QDg = (const bf16_t*)(p.ws + WS_QD);
    const bf16_t* KITg = (const bf16_t*)(p.ws + WS_KIT);
    const float* DECg = (const float*)(p.ws + WS_DEC);
    const bf16_t* AMg = (const bf16_t*)(p.ws + WS_AM);
    bf16_t* OD = (bf16_t*)(p.ws + WS_R2) + (size_t)dir * TT * DM;
    constexpr int QST = 264, TST = 72;
    bf16_t* qd = (bf16_t*)ldsb;
    bf16_t* kinvT = qd + 64 * QST;
    bf16_t* vT = kinvT + 256 * TST;
    float* decay = (float*)(vT + 128 * TST);
    bf16_t* AmatL = (bf16_t*)(decay + 256);
    f32x4 S[16];
    const int vcol = vs * 128 + 16 * w + lr;
    if (s < 16) {
#pragma unroll
        for (int kf = 0; kf < 16; ++kf) S[kf] = (f32x4){0.f, 0.f, 0.f, 0.f};
    } else {
        const float* sp = (dir == 0 ? p.st_f : p.st_b) + ((size_t)((s - 16) * 4 + h) * 256) * 512 + vcol;
#pragma unroll
        for (int kf = 0; kf < 16; ++kf)
#pragma unroll
            for (int r = 0; r < 4; ++r) S[kf][r] = sp[(size_t)(16 * kf + 4 * g + r) * 512];
    }
    uint4 rq0, rq1, rq2, rq3, rk0, rk1, rk2, rk3, rv0, rv1, rm; float rd = 0.f;
#define GB_LOAD(ci_) do { int tid = threadIdx.x; asm volatile("" : "+v"(tid)); const int oc_ = dir ? nch - 1 - (ci_) : (ci_); const int c0_ = tb + oc_ * 64; const size_t it_ = (size_t)((dir * 192 + (c0_ >> 6)) * 4 + h); \
        rq0 = *(const uint4*)(QDg + it_ * 16384 + (size_t)(tid) * 8); rq1 = *(const uint4*)(QDg + it_ * 16384 + (size_t)(tid + 512) * 8); \
        rq2 = *(const uint4*)(QDg + it_ * 16384 + (size_t)(tid + 1024) * 8); rq3 = *(const uint4*)(QDg + it_ * 16384 + (size_t)(tid + 1536) * 8); \
        rk0 = *(const uint4*)(KITg + it_ * 16384 + (size_t)(tid) * 8); rk1 = *(const uint4*)(KITg + it_ * 16384 + (size_t)(tid + 512) * 8); \
        rk2 = *(const uint4*)(KITg + it_ * 16384 + (size_t)(tid + 1024) * 8); rk3 = *(const uint4*)(KITg + it_ * 16384 + (size_t)(tid + 1536) * 8); \
        { const int v = tid >> 3, c = tid & 7; rv0 = *(const uint4*)(VGT + (size_t)(h * 512 + vs * 128 + v) * TT + c0_ + 8 * c); rv1 = *(const uint4*)(VGT + (size_t)(h * 512 + vs * 128 + 64 + v) * TT + c0_ + 8 * c); } \
        rm = *(const uint4*)(AMg + it_ * 4096 + (size_t)tid * 8); \
        if (tid < 256) rd = DECg[it_ * 256 + tid]; } while (0)
#define GB_SQ(i, sq) do { const int id = tid + 512 * (i), ir = id >> 5, c = id & 31; *(uint4*)(qd + ir * QST + 8 * c) = sq; } while (0)
#define GB_SK(i, sk) do { const int id = tid + 512 * (i), k = id >> 3, c = id & 7; *(uint4*)(kinvT + k * TST + 8 * c) = sk; } while (0)
#define GB_SV(i, sv) do { const int id = tid + 512 * (i), v = id >> 3, c = id & 7; uint4 x = sv; \
        if (dir) { uint4 y; y.x = (x.w >> 16) | (x.w << 16); y.y = (x.z >> 16) | (x.z << 16); y.z = (x.y >> 16) | (x.y << 16); y.w = (x.x >> 16) | (x.x << 16); x = y; } \
        *(uint4*)(vT + v * TST + (dir ? 56 - 8 * c : 8 * c)) = x; } while (0)
    GB_LOAD(0);
    for (int ci = 0; ci < nch; ++ci) {
        const int oc = dir ? nch - 1 - ci : ci; const int c0 = tb + oc * 64;
        {
            int tid = threadIdx.x; asm volatile("" : "+v"(tid));
            GB_SQ(0, rq0); GB_SQ(1, rq1); GB_SQ(2, rq2); GB_SQ(3, rq3); GB_SK(0, rk0); GB_SK(1, rk1); GB_SK(2, rk2); GB_SK(3, rk3); GB_SV(0, rv0); GB_SV(1, rv1);
            *(uint4*)(AmatL + (tid >> 3) * TST + 8 * (tid & 7)) = rm;
            if (tid < 256) decay[tid] = rd;
        }
        __syncthreads();
        if (ci + 1 < nch) GB_LOAD(ci + 1);
        f32x4 oT[4];
#pragma unroll
        for (int iff = 0; iff < 4; ++iff) oT[iff] = (f32x4){0.f, 0.f, 0.f, 0.f};
#pragma unroll
        for (int s2 = 0; s2 < 8; ++s2) {
            union { bf16x8 v; unsigned u[4]; } sb;
            sb.u[0] = cvt_pk_bf16(S[2 * s2][0], S[2 * s2][1]); sb.u[1] = cvt_pk_bf16(S[2 * s2][2], S[2 * s2][3]);
            sb.u[2] = cvt_pk_bf16(S[2 * s2 + 1][0], S[2 * s2 + 1][1]); sb.u[3] = cvt_pk_bf16(S[2 * s2 + 1][2], S[2 * s2 + 1][3]);
#pragma unroll
            for (int iff = 0; iff < 4; ++iff) {
                union { bf16x8 v; bf16x4 hh[2]; } b;
                b.hh[0] = *(const bf16x4*)(qd + (16 * iff + lr) * QST + 32 * s2 + 4 * g);
                b.hh[1] = *(const bf16x4*)(qd + (16 * iff + lr) * QST + 32 * s2 + 16 + 4 * g);
                oT[iff] = __builtin_amdgcn_mfma_f32_16x16x32_bf16(sb.v, b.v, oT[iff], 0, 0, 0);
            }
            __builtin_amdgcn_sched_barrier(0);
        }
#pragma unroll
        for (int s2 = 0; s2 < 2; ++s2) {
            const bf16x8 a = *(const bf16x8*)(vT + (16 * w + lr) * TST + 32 * s2 + 8 * g);
#pragma unroll
            for (int iff = 0; iff < 4; ++iff)
                oT[iff] = __builtin_amdgcn_mfma_f32_16x16x32_bf16(a, *(const bf16x8*)(AmatL + (16 * iff + lr) * TST + 32 * s2 + 8 * g), oT[iff], 0, 0, 0);
        }
#pragma unroll
        for (int s2 = 0; s2 < 2; ++s2) {
            const bf16x8 b = *(const bf16x8*)(vT + (16 * w + lr) * TST + 32 * s2 + 8 * g);
#pragma unroll
            for (int kf = 0; kf < 16; ++kf)
            {
                S[kf] = __builtin_amdgcn_mfma_f32_16x16x32_bf16(*(const bf16x8*)(kinvT + (16 * kf + lr) * TST + 32 * s2 + 8 * g), b, S[kf], 0, 0, 0);
                if ((kf & 3) == 3) __builtin_amdgcn_sched_barrier(0);
            }
        }
#pragma unroll
        for (int kf = 0; kf < 16; ++kf) { const f32x4 d = *(const f32x4*)(decay + 16 * kf + 4 * g); S[kf] *= d; }
        asm volatile("s_waitcnt vmcnt(0)" ::: "memory");
#pragma unroll
        for (int iff = 0; iff < 4; ++iff) {
            const int i = 16 * iff + lr;
            const size_t tok = (size_t)(c0 + (dir ? 63 - i : i));
            uint2 o; o.x = cvt_pk_bf16(oT[iff][0], oT[iff][1]); o.y = cvt_pk_bf16(oT[iff][2], oT[iff][3]);
            *(uint2*)(OD + tok * DM + h * 512 + vs * 128 + 16 * w + 4 * g) = o;
        }
        __syncthreads();
    }
#undef GB_LOAD
#undef GB_SQ
#undef GB_SK
#undef GB_SV
    if (s < 16) {
        float* op = p.out + (dir == 0 ? OUT_SF : OUT_SB) + ((size_t)(s * 4 + h) * 256) * 512 + vcol;
#pragma unroll
        for (int kf = 0; kf < 16; ++kf)
#pragma unroll
            for (int r = 0; r < 4; ++r) op[(size_t)(16 * kf + 4 * g + r) * 512] = S[kf][r];
    }
}

__device__ __forceinline__ int queue_pop(const Params& p, unsigned char* lds, int q) {
    unsigned* cnt = (unsigned*)(p.ws + WS_CNT) + q;
    int* slot = (int*)(lds + LDS_BYTES - 16);
    __syncthreads();
    if (threadIdx.x == 0) *slot = (int)atomicAdd(cnt, 1u);
    __syncthreads();
    return *slot;
}
__device__ __forceinline__ void gla_a_phase(const Params& p, unsigned char* lds, int qi) {
    (void)qi;
    for (int it = blockIdx.x; it < 1536; it += gridDim.x) {
        __syncthreads();
        gla_a_item(p, lds, it >> 3, (it >> 1) & 3, it & 1);
    }
}
__device__ __forceinline__ void gla_b_phase(const Params& p, unsigned char* lds, int qi) {
    for (;;) {
        const int it = queue_pop(p, lds, qi);
        if (it >= 640) break;
        int s, h, dir, vs;
        if (it < 128) { s = 16 + (it >> 5); h = (it >> 3) & 3; dir = (it >> 2) & 1; vs = it & 3; }
        else { const int u = it - 128; s = u >> 5; h = (u >> 3) & 3; dir = (u >> 2) & 1; vs = u & 3; }
        gla_b_unit(p, lds, s, h, dir, vs);
    }
    for (;;) {
        const int t = queue_pop(p, lds, qi + 1);
        if (t >= 768) break;
        const int j = t >> 8, tt = t & 255;
        const float* src = j == 0 ? p.w_gla_out : (j == 1 ? p.w_mla_out : p.w_out);
        bf16_t* dst = (bf16_t*)(p.ws + (j == 0 ? WS_WT_G : (j == 1 ? WS_WT_M : WS_WT_OUT)));
        conv_tile((float*)lds, src, 2048, 2048, dst, 0, tt >> 5, tt & 31);
    }
}
__device__ __forceinline__ void attn_phase(const Params& p, unsigned char* lds, int qi = 1) {
    for (;;) {
        const int it = queue_pop(p, lds, qi);
        if (it >= 768) break;
        int s, h, qb;
        if (it < 512) { s = 16 + (it >> 7); h = (it >> 3) & 15; qb = it & 7; }
        else { const int u = it - 512; s = u >> 4; h = u & 15; qb = 0; }
        attn_item(p, lds, s, h, qb);
    }
}

#define XB_TMO      128
#define XB_XCNT(j)  (256  + 64 * (j))
#define XB_XSUB(j)  (1280 + 64 * (j))
#define XB_XGEN(j)  (2304 + 64 * (j))
#define XB_TOP      3328
#define XB_TOPGEN   3392
#define XCD_BAR_WORDS 3456
#define XB_SPIN_CAP (1u << 22)
__device__ __forceinline__ unsigned xb_ld(unsigned* p)              { return __hip_atomic_load(p, __ATOMIC_RELAXED, __HIP_MEMORY_SCOPE_AGENT); }
__device__ __forceinline__ unsigned xb_add(unsigned* p, unsigned v) { return __hip_atomic_fetch_add(p, v, __ATOMIC_RELAXED, __HIP_MEMORY_SCOPE_AGENT); }
__device__ __forceinline__ unsigned xb_xcc_id() { return (unsigned)__builtin_amdgcn_s_getreg((3 << 11) | 20) & 0xFu; }
#define XB_SPIN(cond, bar) do { unsigned _sp = 0; while (cond) { __builtin_amdgcn_s_sleep(1); \
    if ((++_sp & 255u) == 0u) { if (xb_ld(&(bar)[XB_TMO])) break; if (_sp > XB_SPIN_CAP) { atomicAdd(&(bar)[XB_TMO], 1u); break; } } } } while (0)
struct XcdBarrier { unsigned* bar; unsigned x; volatile LAS unsigned* st; };
__device__ __forceinline__ XcdBarrier xcd_barrier_post(unsigned* bar, volatile LAS unsigned* st) {
    XcdBarrier b; b.bar = bar; b.x = xb_xcc_id(); b.st = st;
    if (threadIdx.x == 0) (void)xb_add(&bar[XB_XCNT(b.x)], 1u);
    return b;
}
__device__ __forceinline__ void xcd_barrier_complete(unsigned* bar, unsigned x, unsigned& nloc, unsigned& nx) {
    const unsigned G = gridDim.x * gridDim.y * gridDim.z;
    unsigned sum, cnt, mine, sp = 0u;
    for (;;) {
        sum = 0u; cnt = 0u; mine = 0u;
#pragma unroll
        for (unsigned j = 0; j < 16; ++j) { const unsigned c = xb_ld(&bar[XB_XCNT(j)]); sum += c; cnt += (c > 0u) ? 1u : 0u; mine = (j == x) ? c : mine; }
        if (sum == G) break;
        __builtin_amdgcn_s_sleep(1);
        if ((++sp & 255u) == 0u) { if (xb_ld(&bar[XB_TMO])) break; if (sp > XB_SPIN_CAP) { atomicAdd(&bar[XB_TMO], 1u); break; } }
    }
    nloc = mine > 0u ? mine : 1u; nx = cnt > 0u ? cnt : 1u;
}
__device__ __forceinline__ void xcd_barrier(const XcdBarrier& b) {
    asm volatile("s_waitcnt vmcnt(0)" ::: "memory");
    __syncthreads();
    if (threadIdx.x == 0) {
        unsigned* bar = b.bar;
        __builtin_amdgcn_s_waitcnt(0);
        unsigned nloc = b.st[0], nx = b.st[1];
        if (nloc == 0u) { xcd_barrier_complete(bar, b.x, nloc, nx); b.st[0] = nloc; b.st[1] = nx; }
        const unsigned old = xb_add(&bar[XB_XSUB(b.x)], 1u);
        const unsigned gen = old / nloc;
        if (old + 1u == (gen + 1u) * nloc) {
            __builtin_amdgcn_fence(__ATOMIC_RELEASE, "agent");
            asm volatile("s_waitcnt vmcnt(0)" ::: "memory");
            const unsigned og = xb_add(&bar[XB_TOP], 1u);
            const unsigned tg = og / nx;
            if (og + 1u == (tg + 1u) * nx) xb_add(&bar[XB_TOPGEN], 1u);
            else XB_SPIN(xb_ld(&bar[XB_TOPGEN]) == tg, bar);
            __builtin_amdgcn_fence(__ATOMIC_ACQUIRE, "agent");
            xb_add(&bar[XB_XGEN(b.x)], 1u);
            asm volatile("s_waitcnt vmcnt(0)" ::: "memory");
        } else {
            XB_SPIN(xb_ld(&bar[XB_XGEN(b.x)]) == gen, bar);
            __builtin_amdgcn_fence(__ATOMIC_ACQUIRE, "agent");
            asm volatile("s_waitcnt vmcnt(0)" ::: "memory");
        }
    }
    __syncthreads();
}

__global__ void __launch_bounds__(512) fwd_megakernel(Params p) {
    __builtin_assume(__builtin_amdgcn_workitem_id_y() == 0);
    __builtin_assume(__builtin_amdgcn_workitem_id_z() == 0);
    extern __shared__ __attribute__((aligned(16))) unsigned char lds[];
    cg::grid_group grid = cg::this_grid();
    const int tid = threadIdx.x;
    bf16_t* ws16 = (bf16_t*)p.ws;
    volatile LAS unsigned* xst = (volatile LAS unsigned*)(LAS unsigned char*)(lds + LDS_BYTES - 32);
    if (tid == 0) { xst[0] = 0u; xst[1] = 0u; }
    __syncthreads();
    XcdBarrier xb; xb.bar = (unsigned*)(p.ws + WS_BAR); xb.x = 0; xb.st = xst;
    if (p.phase_hi - p.phase_lo > 1) xb = xcd_barrier_post((unsigned*)(p.ws + WS_BAR), xst);
    if ((ONLY_PHASE < 0 || ONLY_PHASE == 0) && p.phase_lo <= 0 && 0 < p.phase_hi)
    for (int rep_ = 0; rep_ < (PROBE_DUP == 0 ? 2 : 1); ++rep_) {
        if (rep_) xcd_barrier(xb);
        {
            if (blockIdx.x == 0 && tid < 8) ((unsigned*)(p.ws + WS_CNT))[tid] = 0u;
            for (int it = blockIdx.x; it < 288; it += gridDim.x) ada_item(p, (float*)lds, it);
            {
                float* rope = (float*)(p.ws + WS_ROPE);
                const int gi = blockIdx.x * 512 + tid;
                if (gi < 1024) {
                    const int pos = gi >> 4, fi = gi & 15;
                    const double invf = pow(10000.0, -(double)fi / 16.0);
                    const float ang = (float)pos * (float)invf;
                    rope[gi * 2] = (float)cos((double)ang); rope[gi * 2 + 1] = (float)sin((double)ang);
                }
            }
            int base = 288;
            conv_job((float*)lds, base, p.w_ffn1_in, 2048, 11008, (bf16_t*)(p.ws + WS_WT_FFN_IN), 11008, 1);
            conv_job((float*)lds, base, p.w_ffn1_out, 5504, 2048, (bf16_t*)(p.ws + WS_WT_FFN_OUT), 2048, 0);
            conv_job((float*)lds, base, p.w_in, 2048, 11360, (bf16_t*)(p.ws + WS_WT_IN), 11520, 0);
            conv_job((float*)lds, base, p.w_uq, 512, 3072, (bf16_t*)(p.ws + WS_WT_UQ), 3072, 0);
            conv_job((float*)lds, base, p.w_ukv, 512, 4096, (bf16_t*)(p.ws + WS_WT_UKV), 4096, 0);
        }
    }
    if (p.phase_lo <= 0 && 0 + 1 < p.phase_hi) xcd_barrier(xb);
    if (p.phase_lo == -12345) grid.sync();
    if ((ONLY_PHASE < 0 || ONLY_PHASE == 1) && p.phase_lo <= 1 && 1 < p.phase_hi)
    for (int rep_ = 0; rep_ < (PROBE_DUP == 1 ? 2 : 1); ++rep_) {
        if (rep_) xcd_barrier(xb);
        {
            const float* modp = (const float*)(p.ws + WS_MODP);
            float* mod = (float*)(p.ws + WS_MOD);
            for (int i = blockIdx.x * 512 + tid; i < 5 * 18432; i += gridDim.x * 512) {
                const int n = i % 18432;
                mod[i] = p.b_ada[n] + modp[i] + modp[i + 5 * 18432] + modp[i + 2 * 5 * 18432] + modp[i + 3 * 5 * 18432];
            }
        }
    }
    if (p.phase_lo <= 1 && 1 + 1 < p.phase_hi) xcd_barrier(xb);
    if ((ONLY_PHASE < 0 || ONLY_PHASE == 2) && p.phase_lo <= 2 && 2 < p.phase_hi)
    for (int rep_ = 0; rep_ < (PROBE_DUP == 2 ? 2 : 1); ++rep_) {
        if (rep_) xcd_barrier(xb);
        row_phase(p, 1);
    }
    if (p.phase_lo <= 2 && 2 + 1 < p.phase_hi) xcd_barrier(xb);
    if ((ONLY_PHASE < 0 || ONLY_PHASE == 3) && p.phase_lo <= 3 && 3 < p.phase_hi)
    for (int rep_ = 0; rep_ < (PROBE_DUP == 3 ? 2 : 1); ++rep_) {
        if (rep_) xcd_barrier(xb);
        { EpiSwiglu e{(bf16_t*)(p.ws + WS_R1)}; run_gemm(lds, (const bf16_t*)(p.ws + WS_H), (const bf16_t*)(p.ws + WS_WT_FFN_IN), TT, 11008, 2048, e); }
    }
    if (p.phase_lo <= 3 && 3 + 1 < p.phase_hi) xcd_barrier(xb);
    if ((ONLY_PHASE < 0 || ONLY_PHASE == 4) && p.phase_lo <= 4 && 4 < p.phase_hi)
    for (int rep_ = 0; rep_ < (PROBE_DUP == 4 ? 2 : 1); ++rep_) {
        if (rep_) xcd_barrier(xb);
        { EpiF32 e{(bf16_t*)(p.ws + WS_R2), DM, (bf16_t*)(p.ws + WS_Y1)}; run_gemm(lds, (const bf16_t*)(p.ws + WS_R1), (const bf16_t*)(p.ws + WS_WT_FFN_OUT), TT, 2048, DFF, e, 2); }
    }
    if (p.phase_lo <= 4 && 4 + 1 < p.phase_hi) xcd_barrier(xb);
    if ((ONLY_PHASE < 0 || ONLY_PHASE == 5) && p.phase_lo <= 5 && 5 < p.phase_hi)
    for (int rep_ = 0; rep_ < (PROBE_DUP == 5 ? 2 : 1); ++rep_) {
        if (rep_) xcd_barrier(xb);
        row_phase(p, 2);
    }
    if (p.phase_lo <= 5 && 5 + 1 < p.phase_hi) xcd_barrier(xb);
    if ((ONLY_PHASE < 0 || ONLY_PHASE == 6) && p.phase_lo <= 6 && 6 < p.phase_hi)
    for (int rep_ = 0; rep_ < (PROBE_DUP == 6 ? 2 : 1); ++rep_) {
        if (rep_) xcd_barrier(xb);
        { EpiProj e{(bf16_t*)(p.ws + WS_R1), (bf16_t*)(p.ws + WS_VGT), (float*)(p.ws + WS_SMALL)}; run_gemm(lds, (const bf16_t*)(p.ws + WS_H), (const bf16_t*)(p.ws + WS_WT_IN), TT, 11520, 2048, e); }
    }
    if (p.phase_lo <= 6 && 6 + 1 < p.phase_hi) xcd_barrier(xb);
    if ((ONLY_PHASE < 0 || ONLY_PHASE == 7) && p.phase_lo <= 7 && 7 < p.phase_hi)
    for (int rep_ = 0; rep_ < (PROBE_DUP == 7 ? 2 : 1); ++rep_) {
        if (rep_) xcd_barrier(xb);
        {
            token_phase(p);
        }
    }
    if (p.phase_lo <= 7 && 7 + 1 < p.phase_hi) xcd_barrier(xb);
    if ((ONLY_PHASE < 0 || ONLY_PHASE == 8) && p.phase_lo <= 8 && 8 < p.phase_hi)
    for (int rep_ = 0; rep_ < (PROBE_DUP == 8 ? 2 : 1); ++rep_) {
        if (rep_) xcd_barrier(xb);
        { EpiQ e{(bf16_t*)(p.ws + WS_Q), (const float*)(p.ws + WS_ROPE)}; run_gemm(lds, (const bf16_t*)(p.ws + WS_CQN), (const bf16_t*)(p.ws + WS_WT_UQ), TT, 3072, 512, e); }
    }
    if (p.phase_lo <= 8 && 8 + 1 < p.phase_hi) xcd_barrier(xb);
    if ((ONLY_PHASE < 0 || ONLY_PHASE == 9) && p.phase_lo <= 9 && 9 < p.phase_hi)
    for (int rep_ = 0; rep_ < (PROBE_DUP == 9 ? 2 : 1); ++rep_) {
        if (rep_) xcd_barrier(xb);
        { EpiKV e{(bf16_t*)(p.ws + WS_KN), (bf16_t*)(p.ws + WS_VT)}; run_gemm(lds, (const bf16_t*)(p.ws + WS_CKVA), (const bf16_t*)(p.ws + WS_WT_UKV), KVR, 4096, 512, e); }
    }
    if (p.phase_lo <= 9 && 9 + 1 < p.phase_hi) xcd_barrier(xb);
    if ((ONLY_PHASE < 0 || ONLY_PHASE == 10) && p.phase_lo <= 10 && 10 < p.phase_hi)
    for (int rep_ = 0; rep_ < (PROBE_DUP == 10 ? 2 : 1); ++rep_) {
        if (rep_) xcd_barrier(xb);
        attn_phase(p, lds, rep_ ? 5 : 1);
    }
    if (p.phase_lo <= 10 && 10 + 1 < p.phase_hi) xcd_barrier(xb);
    if ((ONLY_PHASE < 0 || ONLY_PHASE == 11) && p.phase_lo <= 11 && 11 < p.phase_hi)
    for (int rep_ = 0; rep_ < (PROBE_DUP == 11 ? 2 : 1); ++rep_) {
        if (rep_) xcd_barrier(xb);
        gla_a_phase(p, lds, rep_ ? 4 : 0);
    }
    if (p.phase_lo <= 11 && 11 + 1 < p.phase_hi) xcd_barrier(xb);
    if ((ONLY_PHASE < 0 || ONLY_PHASE == 12) && p.phase_lo <= 12 && 12 < p.phase_hi)
    for (int rep_ = 0; rep_ < (PROBE_DUP == 12 ? 2 : 1); ++rep_) {
        if (rep_) xcd_barrier(xb);
        gla_b_phase(p, lds, rep_ ? 6 : 2);
    }
    if (p.phase_lo <= 12 && 12 + 1 < p.phase_hi) xcd_barrier(xb);
    if ((ONLY_PHASE < 0 || ONLY_PHASE == 13) && p.phase_lo <= 13 && 13 < p.phase_hi)
    for (int rep_ = 0; rep_ < (PROBE_DUP == 13 ? 2 : 1); ++rep_) {
        if (rep_) xcd_barrier(xb);
        gla_post_phase(p);
    }
    if (p.phase_lo <= 13 && 13 + 1 < p.phase_hi) xcd_barrier(xb);
    if ((ONLY_PHASE < 0 || ONLY_PHASE == 14) && p.phase_lo <= 14 && 14 < p.phase_hi)
    for (int rep_ = 0; rep_ < (PROBE_DUP == 14 ? 2 : 1); ++rep_) {
        if (rep_) xcd_barrier(xb);
        { EpiGate e{(const bf16_t*)(p.ws + WS_R1), (bf16_t*)(p.ws + WS_H)}; run_gemm(lds, (const bf16_t*)(p.ws + WS_Q), (const bf16_t*)(p.ws + WS_WT_G), TT, 2048, 2048, e, 1, (const bf16_t*)(p.ws + WS_OM), (const bf16_t*)(p.ws + WS_WT_M)); }
        {
            const int G = gridDim.x, nfull = 384 - G > 0 ? 384 - G : 0;
            int wb = (int)blockIdx.x - nfull, nw = G - nfull;
            if (nw <= 0) { wb = blockIdx.x; nw = G; }
            if (wb >= 0) {
                int base = 0;
                conv_job((float*)lds, base, p.w_ffn2_in, 2048, 11008, (bf16_t*)(p.ws + WS_WT_FFN_IN), 11008, 1, wb, nw);
                conv_job((float*)lds, base, p.w_ffn2_out, 5504, 2048, (bf16_t*)(p.ws + WS_WT_FFN_OUT), 2048, 0, wb, nw);
            }
        }
    }
    if (p.phase_lo <= 14 && 14 + 1 < p.phase_hi) xcd_barrier(xb);
    if ((ONLY_PHASE < 0 || ONLY_PHASE == 15) && p.phase_lo <= 15 && 15 < p.phase_hi)
    for (int rep_ = 0; rep_ < (PROBE_DUP == 15 ? 2 : 1); ++rep_) {
        if (rep_) xcd_barrier(xb);
        { EpiF32 e{(bf16_t*)(p.ws + WS_R2), DM, (bf16_t*)(p.ws + WS_Y1)}; run_gemm(lds, (const bf16_t*)(p.ws + WS_H), (const bf16_t*)(p.ws + WS_WT_OUT), TT, 2048, 2048, e, 2); }
    }
    if (p.phase_lo <= 15 && 15 + 1 < p.phase_hi) xcd_barrier(xb);
    if ((ONLY_PHASE < 0 || ONLY_PHASE == 16) && p.phase_lo <= 16 && 16 < p.phase_hi)
    for (int rep_ = 0; rep_ < (PROBE_DUP == 16 ? 2 : 1); ++rep_) {
        if (rep_) xcd_barrier(xb);
        row_phase(p, 3);
    }
    if (p.phase_lo <= 16 && 16 + 1 < p.phase_hi) xcd_barrier(xb);
    if ((ONLY_PHASE < 0 || ONLY_PHASE == 17) && p.phase_lo <= 17 && 17 < p.phase_hi)
    for (int rep_ = 0; rep_ < (PROBE_DUP == 17 ? 2 : 1); ++rep_) {
        if (rep_) xcd_barrier(xb);
        { EpiSwiglu e{(bf16_t*)(p.ws + WS_R1)}; run_gemm(lds, (const bf16_t*)(p.ws + WS_H), (const bf16_t*)(p.ws + WS_WT_FFN_IN), TT, 11008, 2048, e); }
    }
    if (p.phase_lo <= 17 && 17 + 1 < p.phase_hi) xcd_barrier(xb);
    if ((ONLY_PHASE < 0 || ONLY_PHASE == 18) && p.phase_lo <= 18 && 18 < p.phase_hi)
    for (int rep_ = 0; rep_ < (PROBE_DUP == 18 ? 2 : 1); ++rep_) {
        if (rep_) xcd_barrier(xb);
        { EpiF32 e{(bf16_t*)(p.ws + WS_R2), DM, (bf16_t*)(p.ws + WS_Y1)}; run_gemm(lds, (const bf16_t*)(p.ws + WS_R1), (const bf16_t*)(p.ws + WS_WT_FFN_OUT), TT, 2048, DFF, e, 2); }
    }
    if (p.phase_lo <= 18 && 18 + 1 < p.phase_hi) xcd_barrier(xb);
    if ((ONLY_PHASE < 0 || ONLY_PHASE == 19) && p.phase_lo <= 19 && 19 < p.phase_hi)
    for (int rep_ = 0; rep_ < (PROBE_DUP == 19 ? 2 : 1); ++rep_) {
        if (rep_) xcd_barrier(xb);
        row_phase(p, 4);
    }
    (void)ws16;
}

extern "C" void kernel_launch(void* const* d_in, const int* in_sizes, int n_in, void* d_out, int out_size, void* d_ws, size_t ws_size, hipStream_t stream) {
    (void)in_sizes; (void)n_in; (void)out_size;
    static int grid_blocks = 0;
    if (!grid_blocks) {
        hipFuncSetAttribute((const void*)fwd_megakernel, hipFuncAttributeMaxDynamicSharedMemorySize, LDS_BYTES);
        int dev = 0, cus = 0, per_cu = 0;
        hipGetDevice(&dev);
        hipDeviceGetAttribute(&cus, hipDeviceAttributeMultiprocessorCount, dev);
        hipOccupancyMaxActiveBlocksPerMultiprocessor(&per_cu, fwd_megakernel, 512, LDS_BYTES);
        if (per_cu < 1) per_cu = 1;
        grid_blocks = cus * 1;
    }
    if (ws_size < WS_END) { fprintf(stderr, "workspace too small: %zu < %zu\n", ws_size, (size_t)WS_END); return; }
    Params p{};
    const float* const* in = (const float* const*)d_in;
    p.x_prompt = in[0]; p.x_sample = in[1]; p.cache_ckv = in[2]; p.cache_krope = in[3]; p.st_f = in[4]; p.st_b = in[5]; p.c = in[6]; p.c_ctx = in[7];
    p.w_ada = in[8]; p.b_ada = in[9]; p.norm_gains = in[10]; p.w_ffn1_in = in[11]; p.w_ffn1_out = in[12]; p.w_ffn2_in = in[13]; p.w_ffn2_out = in[14];
    p.w_in = in[15]; p.w_gla_alpha = in[16]; p.b_gla_alpha = in[17]; p.gla_norm = in[18]; p.w_gla_out = in[19]; p.q_norm = in[20]; p.kv_norm = in[21];
    p.w_uq = in[22]; p.w_ukv = in[23]; p.w_mla_out = in[24]; p.w_out = in[25];
    p.out = (float*)d_out; p.ws = (char*)d_ws;
#if N_LAUNCH_SPLIT
    for (int ph = 0; ph < NPHASE; ++ph) {
        p.phase_lo = ph; p.phase_hi = ph + 1;
        hipLaunchKernelGGL(fwd_megakernel, dim3(grid_blocks), dim3(512), LDS_BYTES, stream, p);
    }
#else
    p.phase_lo = 0; p.phase_hi = NPHASE;
    (void)hipMemsetAsync((char*)d_ws + WS_BAR, 0, XCD_BAR_WORDS * 4, stream);
    void* args[] = {&p};
    hipError_t e = hipLaunchCooperativeKernel((const void*)fwd_megakernel, dim3(grid_blocks), dim3(512), args, LDS_BYTES, stream);
    if (e != hipSuccess) fprintf(stderr, "cooperative launch failed: %s (grid %d)\n", hipGetErrorString(e), grid_blocks);
#endif
}
```
